# Optimizing an MI355X kernel written in HIP

```python
import math
import jax, jax.numpy as jnp
from jax import lax
import numpy as np

D_MODEL = 1024
BATCH = 2
SEQ = 8192
DEPTH = 2

GRID_W = 64
CTX_LEN = 256
EPS = 1e-6
NEG_INF = -1e30

NA_HEADS = 8
NA_HEAD_DIM = 64
NA_WIN_H = 8
NA_WIN_W = 16
NA_QBLOCK = NA_WIN_W
NA_KBLOCK = 2 * NA_WIN_W
NA_WIDTH = NA_HEADS * NA_HEAD_DIM
SG_GROUPS = 8
SG_GROUP_DIM = 64
SG_CHUNK = 128
SG_WIDTH = SG_GROUPS * SG_GROUP_DIM
AB_IN = 3 * NA_WIDTH + 2 * SG_WIDTH
AB_OUT = NA_WIDTH + SG_WIDTH

RET_HEADS = 4
RET_QK_DIM = 256
RET_V_DIM = 512
RET_CHUNK = 128
RET_QK_WIDTH = RET_HEADS * RET_QK_DIM
RET_V_WIDTH = RET_HEADS * RET_V_DIM
RET_IN = 2 * RET_QK_WIDTH + 2 * RET_V_WIDTH
ROPE_BASE = 10000.0

N_EXPERTS = 16
EC_CAPACITY = 2
D_FF_EXPERT = 2816

N_EVEN = (DEPTH + 1) // 2
N_ODD = DEPTH // 2

kernel_name = "hybrid_natten_sgu_retention_ecmoe_dit"

F32 = jnp.float32


def rmsnorm(x, g):
    xf = x.astype(F32)
    y = xf * lax.rsqrt(jnp.mean(xf * xf, axis=-1, keepdims=True) + EPS)
    return (y * g.astype(F32)).astype(x.dtype)


def adaln(cond, w, b):
    m = jax.nn.silu(cond) @ w + b
    return jnp.split(m[..., None, :], 6, axis=-1)


def modulate(h, shift, scale):
    return h * (1 + scale) + shift


def to_heads(t, n_heads):
    b, l, _ = t.shape
    return t.reshape(b, l, n_heads, -1).transpose(0, 2, 1, 3)


def from_heads(t):
    b, h, l, d = t.shape
    return t.transpose(0, 2, 1, 3).reshape(b, l, h * d)


def axial_rope_tables(rows, dim):
    axis_dim = dim // 2
    inv = 1.0 / (ROPE_BASE ** (jnp.arange(0, axis_dim, 2, dtype=F32) / axis_dim))
    t = jnp.arange(rows * GRID_W)
    r = (t // GRID_W).astype(F32)
    col = (t % GRID_W).astype(F32)
    ang = jnp.concatenate([r[:, None] * inv, col[:, None] * inv], axis=-1)
    return jnp.cos(ang), jnp.sin(ang)


def apply_rope(x, cos, sin):
    x1, x2 = jnp.split(x, 2, axis=-1)
    return jnp.concatenate([x1 * cos - x2 * sin, x1 * sin + x2 * cos], axis=-1).astype(x.dtype)


def dense_attention(q, k, v):
    s = jnp.einsum('bhqd,bhkd->bhqk', q, k).astype(F32) * (q.shape[-1] ** -0.5)
    p = jax.nn.softmax(s, axis=-1).astype(v.dtype)
    return jnp.einsum('bhqk,bhkd->bhqd', p, v)


def neighbourhood_attention(q, k, v, k_ctx, v_ctx, rpb):
    B, H, L, d = q.shape
    rows = L // GRID_W
    kh = min(NA_WIN_H, rows)
    ncb = GRID_W // NA_QBLOCK
    scale = d ** -0.5
    qcol = np.arange(GRID_W).reshape(ncb, NA_QBLOCK)
    cstart = np.clip(qcol - NA_WIN_W // 2, 0, GRID_W - NA_WIN_W)
    kc0 = np.minimum(cstart[:, 0], GRID_W - NA_KBLOCK)
    kcol = kc0[:, None] + np.arange(NA_KBLOCK)
    col_ok = (kcol[:, None, :] >= cstart[:, :, None]) & (kcol[:, None, :] < cstart[:, :, None] + NA_WIN_W)
    dcol = np.clip(kcol[:, None, :] - qcol[:, :, None], 1 - NA_WIN_W, NA_WIN_W - 1) + NA_WIN_W - 1
    mask = jnp.asarray(col_ok)[:, :, None, :]
    qg = q.reshape(B, H, rows, ncb, NA_QBLOCK, d)
    kg = k.reshape(B, H, rows, GRID_W, d)
    vg = v.reshape(B, H, rows, GRID_W, d)
    nk = kh * NA_KBLOCK

    def row_block(i):
        r0 = jnp.clip(i - kh // 2, 0, rows - kh)
        k_blk = lax.dynamic_slice_in_dim(kg, r0, kh, axis=2)[:, :, :, kcol]
        v_blk = lax.dynamic_slice_in_dim(vg, r0, kh, axis=2)[:, :, :, kcol]
        q_row = lax.dynamic_index_in_dim(qg, i, axis=2, keepdims=False)
        s_nb = jnp.einsum('bhcqd,bhrckd->bhcqrk', q_row, k_blk).astype(F32) * scale
        drow = r0 + jnp.arange(kh) - i + NA_WIN_H - 1
        bias = rpb[:, drow][:, :, dcol].astype(F32)
        s_nb = jnp.where(mask, s_nb + jnp.transpose(bias, (0, 2, 3, 1, 4)), NEG_INF)
        s_c = jnp.einsum('bhcqd,bhkd->bhcqk', q_row, k_ctx).astype(F32) * scale
        s = jnp.concatenate([s_nb.reshape(B, H, ncb, NA_QBLOCK, nk), s_c], axis=-1)
        p = jax.nn.softmax(s, axis=-1).astype(v.dtype)
        p_nb = p[..., :nk].reshape(B, H, ncb, NA_QBLOCK, kh, NA_KBLOCK)
        p_c = p[..., nk:]
        return (jnp.einsum('bhcqrk,bhrckd->bhcqd', p_nb, v_blk)
                + jnp.einsum('bhcqk,bhkd->bhcqd', p_c, v_ctx))

    out = lax.map(row_block, jnp.arange(rows))
    return jnp.moveaxis(out, 0, 2).reshape(B, H, L, d)


def spatial_gating(u, v, norm_g, w_s, b_s):
    b, l, _ = v.shape
    vn = rmsnorm(v, norm_g).reshape(b, l // SG_CHUNK, SG_CHUNK, SG_GROUPS, SG_GROUP_DIM)
    mixed = jnp.einsum('gpq,bnqgc->bnpgc', w_s, vn) + b_s.T[:, :, None]
    return u * mixed.reshape(b, l, SG_WIDTH)


def na_sgu_mixer(h, h_ctx, w_in, w_out, rpb, sgu_g, sgu_w, sgu_b, with_ctx_out):
    o1, o3, o4 = NA_WIDTH, 3 * NA_WIDTH, 3 * NA_WIDTH + SG_WIDTH
    z = h @ w_in
    q = to_heads(z[..., :o1], NA_HEADS)
    k = to_heads(z[..., o1:2 * o1], NA_HEADS)
    v = to_heads(z[..., 2 * o1:o3], NA_HEADS)
    u = jax.nn.gelu(z[..., o3:o4])
    gv = jax.nn.gelu(z[..., o4:])
    zc_kv = h_ctx @ w_in[:, o1:o3]
    k_c = to_heads(zc_kv[..., :NA_WIDTH], NA_HEADS)
    v_c = to_heads(zc_kv[..., NA_WIDTH:], NA_HEADS)
    a = from_heads(neighbourhood_attention(q, k, v, k_c, v_c, rpb))
    bsg = spatial_gating(u, gv, sgu_g, sgu_w, sgu_b)
    y = jnp.concatenate([a, bsg], axis=-1) @ w_out
    if not with_ctx_out:
        return y, None
    q_c = to_heads(h_ctx @ w_in[:, :o1], NA_HEADS)
    zc_ug = jax.nn.gelu(h_ctx @ w_in[:, o3:])
    a_c = from_heads(dense_attention(q_c, k_c, v_c))
    b_c = spatial_gating(zc_ug[..., :SG_WIDTH], zc_ug[..., SG_WIDTH:], sgu_g, sgu_w, sgu_b)
    y_c = jnp.concatenate([a_c, b_c], axis=-1) @ w_out
    return y, y_c


def retention_scan(q, k, v, log_gamma, s0):
    B, H, L, dk = q.shape
    dv = v.shape[-1]
    C = RET_CHUNK
    n = L // C
    chunks = lambda t: jnp.moveaxis(t.astype(F32).reshape(B, H, n, C, t.shape[-1]), 2, 0)
    idx = jnp.arange(C, dtype=F32)
    diff = idx[:, None] - idx[None, :]
    decay_in = jnp.where(diff >= 0, jnp.exp(jnp.maximum(diff, 0.0) * log_gamma[:, None, None]), 0.0)
    q_decay = jnp.exp((idx + 1) * log_gamma[:, None])[:, :, None]
    k_decay = jnp.exp((C - 1 - idx) * log_gamma[:, None])[:, :, None]
    chunk_decay = jnp.exp(C * log_gamma)[:, None, None]

    def step(s, inp):
        qj, kj, vj = inp
        att = jnp.einsum('bhqd,bhkd->bhqk', qj, kj) * decay_in
        o = jnp.einsum('bhqk,bhkv->bhqv', att, vj) + jnp.einsum('bhqd,bhdv->bhqv', qj, s) * q_decay
        s_new = s * chunk_decay + jnp.einsum('bhkd,bhkv->bhdv', kj * k_decay, vj)
        return s_new, o

    s_fin, o = lax.scan(step, s0, (chunks(q), chunks(k), chunks(v)))
    return jnp.moveaxis(o, 0, 2).reshape(B, H, L, dv), s_fin


def retention_final_state(k, v, log_gamma):
    L = k.shape[2]
    w = jnp.exp((L - 1 - jnp.arange(L, dtype=F32))[None, :] * log_gamma[:, None])
    return jnp.einsum('bhld,bhlv,hl->bhdv', k.astype(F32), v.astype(F32), w)


def retention_output(o, g, w_out):
    of = o.astype(F32)
    of = of * lax.rsqrt(jnp.mean(of * of, axis=-1, keepdims=True) + EPS)
    y = from_heads(of.astype(g.dtype))
    return (jax.nn.silu(g) * y) @ w_out


def retention_mixer(h, h_ctx, w_in, w_out, decay_logit, cos, sin, with_ctx_out):
    o1, o2, o3 = RET_QK_WIDTH, 2 * RET_QK_WIDTH, 2 * RET_QK_WIDTH + RET_V_WIDTH
    kscale = RET_QK_DIM ** -0.5
    z = h @ w_in
    q = apply_rope(to_heads(z[..., :o1], RET_HEADS), cos, sin)
    k = apply_rope(to_heads(z[..., o1:o2], RET_HEADS), cos, sin) * kscale
    v = to_heads(z[..., o2:o3], RET_HEADS)
    g = z[..., o3:]
    zc_kv = h_ctx @ w_in[:, o1:o3]
    k_c = to_heads(zc_kv[..., :RET_QK_WIDTH], RET_HEADS) * kscale
    v_c = to_heads(zc_kv[..., RET_QK_WIDTH:], RET_HEADS)
    if with_ctx_out:
        q_c = to_heads(h_ctx @ w_in[:, :o1], RET_HEADS)
        g_c = h_ctx @ w_in[:, o3:]
    log_gamma = jax.nn.log_sigmoid(decay_logit.astype(F32))
    bc = h_ctx.shape[0]
    lat_outs = []
    ctx_outs = []
    for direction in range(2):
        f = (lambda t: jnp.flip(t, axis=2)) if direction == 1 else (lambda t: t)
        lg = log_gamma[direction]
        if with_ctx_out:
            s0 = jnp.zeros((bc, RET_HEADS, RET_QK_DIM, RET_V_DIM), F32)
            oc, s_c = retention_scan(f(q_c), f(k_c), f(v_c), lg, s0)
            ctx_outs.append(f(oc))
        else:
            s_c = retention_final_state(f(k_c), f(v_c), lg)
        ol, _ = retention_scan(f(q), f(k), f(v), lg, s_c)
        lat_outs.append(f(ol))
    y = retention_output(lat_outs[0] + lat_outs[1], g, w_out)
    if not with_ctx_out:
        return y, None
    y_c = retention_output(ctx_outs[0] + ctx_outs[1], g_c, w_out)
    return y, y_c


def expert_choice_ffn(h, w_router, w_gate, w_up, w_down):
    B, N, _ = h.shape
    cap = EC_CAPACITY * N // N_EXPERTS
    aff = jax.nn.softmax(jnp.einsum('bnd,de->bne', h, w_router).astype(F32), axis=-1)
    gate, idx = lax.top_k(jnp.swapaxes(aff, 1, 2), cap)
    bidx = jnp.arange(B)[:, None, None]
    xe = h[bidx, idx]
    hid = jax.nn.silu(jnp.einsum('becd,edf->becf', xe, w_gate)) * jnp.einsum('becd,edf->becf', xe, w_up)
    ye = jnp.einsum('becf,efd->becd', hid, w_down) * gate[..., None].astype(h.dtype)
    return jnp.zeros_like(h).at[bidx, idx].add(ye)


def setup_inputs(seed: int = 0) -> dict:
    key = jax.random.key(seed)
    ks = jax.random.split(key, 24)
    nrm = lambda k, shape, fan_in: jax.random.normal(k, shape, F32) * (fan_in ** -0.5)
    noise = lambda k, shape, s: jax.random.normal(k, shape, F32) * s
    base_logit = jnp.log(2.0 ** (5.0 + jnp.arange(RET_HEADS, dtype=F32)) - 1.0)
    return {
        "x": jax.random.normal(ks[0], (BATCH, SEQ, D_MODEL), F32),
        "c": jax.random.normal(ks[1], (BATCH, D_MODEL), F32),
        "ctx": jax.random.normal(ks[2], (BATCH, CTX_LEN, D_MODEL), F32),
        "c_ctx": jax.random.normal(ks[3], (D_MODEL,), F32),
        "ada_w": nrm(ks[4], (DEPTH, D_MODEL, 6 * D_MODEL), D_MODEL),
        "ada_b": noise(ks[5], (DEPTH, 6 * D_MODEL), 0.01),
        "norm1_g": 1.0 + noise(ks[6], (DEPTH, D_MODEL), 0.02),
        "norm2_g": 1.0 + noise(ks[7], (DEPTH, D_MODEL), 0.02),
        "ab_w_in": nrm(ks[8], (N_EVEN, D_MODEL, AB_IN), D_MODEL),
        "ab_w_out": nrm(ks[9], (N_EVEN, AB_OUT, D_MODEL), AB_OUT),
        "na_rpb": noise(ks[10], (N_EVEN, NA_HEADS, 2 * NA_WIN_H - 1, 2 * NA_WIN_W - 1), 0.02),
        "sgu_norm_g": 1.0 + noise(ks[11], (N_EVEN, SG_WIDTH), 0.02),
        "sgu_w": nrm(ks[12], (N_EVEN, SG_GROUPS, SG_CHUNK, SG_CHUNK), SG_CHUNK),
        "sgu_b": 1.0 + noise(ks[13], (N_EVEN, SG_GROUPS, SG_CHUNK), 0.01),
        "ret_w_in": nrm(ks[14], (N_ODD, D_MODEL, RET_IN), D_MODEL),
        "ret_w_out": nrm(ks[15], (N_ODD, RET_V_WIDTH, D_MODEL), RET_V_WIDTH),
        "ret_decay_logit": base_logit + noise(ks[16], (N_ODD, 2, RET_HEADS), 0.05),
        "moe_router": nrm(ks[17], (DEPTH, D_MODEL, N_EXPERTS), D_MODEL),
        "moe_w_gate": nrm(ks[18], (DEPTH, N_EXPERTS, D_MODEL, D_FF_EXPERT), D_MODEL),
        "moe_w_up": nrm(ks[19], (DEPTH, N_EXPERTS, D_MODEL, D_FF_EXPERT), D_MODEL),
        "moe_w_down": nrm(ks[20], (DEPTH, N_EXPERTS, D_FF_EXPERT, D_MODEL), D_FF_EXPERT),
        "final_norm_g": 1.0 + noise(ks[21], (D_MODEL,), 0.02),
    }


def reference(x, c, ctx, c_ctx, ada_w, ada_b, norm1_g, norm2_g, ab_w_in, ab_w_out, na_rpb,
              sgu_norm_g, sgu_w, sgu_b, ret_w_in, ret_w_out, ret_decay_logit,
              moe_router, moe_w_gate, moe_w_up, moe_w_down, final_norm_g):
    L = x.shape[1]
    rows = L // GRID_W
    cos, sin = axial_rope_tables(rows, RET_QK_DIM)
    xc = ctx
    for layer in range(DEPTH):
        last = layer == DEPTH - 1
        sh1, sc1, g1, sh2, sc2, g2 = adaln(c, ada_w[layer], ada_b[layer])
        csh1, csc1, cg1, csh2, csc2, cg2 = adaln(c_ctx, ada_w[layer], ada_b[layer])
        h = modulate(rmsnorm(x, norm1_g[layer]), sh1, sc1)
        hc = modulate(rmsnorm(xc, norm1_g[layer]), csh1, csc1)
        if layer % 2 == 0:
            j = layer // 2
            y, y_c = na_sgu_mixer(h, hc, ab_w_in[j], ab_w_out[j], na_rpb[j],
                                  sgu_norm_g[j], sgu_w[j], sgu_b[j], not last)
        else:
            j = layer // 2
            y, y_c = retention_mixer(h, hc, ret_w_in[j], ret_w_out[j], ret_decay_logit[j],
                                     cos, sin, not last)
        x = x + g1 * y
        h2 = modulate(rmsnorm(x, norm2_g[layer]), sh2, sc2)
        x = x + g2 * expert_choice_ffn(h2, moe_router[layer], moe_w_gate[layer],
                                       moe_w_up[layer], moe_w_down[layer])
        if not last:
            xc = xc + cg1 * y_c
            hc2 = modulate(rmsnorm(xc, norm2_g[layer]), csh2, csc2)
            xc = xc + cg2 * expert_choice_ffn(hc2, moe_router[layer], moe_w_gate[layer],
                                              moe_w_up[layer], moe_w_down[layer])
    return rmsnorm(x, final_norm_g)
```

```cpp
#include <hip/hip_runtime.h>
#include <stdint.h>
#include <cstdio>

#define LAS __attribute__((address_space(3)))
typedef unsigned short bf16_t;
typedef short bf16x8 __attribute__((ext_vector_type(8)));
typedef float f32x4 __attribute__((ext_vector_type(4)));
typedef float f32x2 __attribute__((ext_vector_type(2)));
typedef unsigned u32x4 __attribute__((ext_vector_type(4)));
typedef unsigned u32x2 __attribute__((ext_vector_type(2)));

namespace {
constexpr int D = 1024, NB = 2, SEQ = 8192, CTX = 256;
constexpr int ML = NB * SEQ;
constexpr int MC = NB * CTX;
constexpr int MT = ML + MC;
constexpr int ABIN = 2560;
constexpr int RIN = 6144;
constexpr int NE = 16, FF = 2816, CAPL = 1024, CAPC = 32;
constexpr int MEXP = 2304;
constexpr float EPS = 1e-6f;
constexpr int MODW = 6 * D;
constexpr int NWG = 256, NTHR = 512;
constexpr int LDS_STAGE = 131072, LDS_IDX = 16384, LDS_BYTES = LDS_STAGE + LDS_IDX + 8192;

__device__ __forceinline__ float bf2f(bf16_t v) { return __uint_as_float((unsigned)v << 16); }
__device__ __forceinline__ bf16_t f2bf(float v) { unsigned u = __float_as_uint(v); u += 0x7fffu + ((u >> 16) & 1u); return (bf16_t)(u >> 16); }
__device__ __forceinline__ float rbf(float v) { return bf2f(f2bf(v)); }
typedef __bf16 bf16v2_t __attribute__((ext_vector_type(2)));
__device__ __forceinline__ unsigned cvt_pk_bf16(float lo, float hi) { const f32x2 v = {lo, hi}; const bf16v2_t r = __builtin_convertvector(v, bf16v2_t); return __builtin_bit_cast(unsigned, r); }

__device__ __forceinline__ int tidx() { int t = threadIdx.x; asm volatile("" : "+v"(t)); return t; }

#define WAVE_ALLREDUCE(OP) \
    v = OP(v, __uint_as_float((unsigned)__builtin_amdgcn_update_dpp(0, (int)__float_as_uint(v), 0xB1, 0xf, 0xf, true)));    \
    v = OP(v, __uint_as_float((unsigned)__builtin_amdgcn_update_dpp(0, (int)__float_as_uint(v), 0x4E, 0xf, 0xf, true)));    \
    v = OP(v, __uint_as_float((unsigned)__builtin_amdgcn_update_dpp(0, (int)__float_as_uint(v), 0x141, 0xf, 0xf, true)));   \
    v = OP(v, __uint_as_float((unsigned)__builtin_amdgcn_update_dpp(0, (int)__float_as_uint(v), 0x140, 0xf, 0xf, true)));   \
    { const auto r = __builtin_amdgcn_permlane16_swap(__float_as_uint(v), __float_as_uint(v), false, false); v = OP(__uint_as_float(r[0]), __uint_as_float(r[1])); } \
    { const auto r = __builtin_amdgcn_permlane32_swap(__float_as_uint(v), __float_as_uint(v), false, false); v = OP(__uint_as_float(r[0]), __uint_as_float(r[1])); }
__device__ __forceinline__ float op_add(float a, float b) { return a + b; }
__device__ __forceinline__ float wave_sum(float v) { WAVE_ALLREDUCE(op_add) return v; }
__device__ __forceinline__ float wave_max(float v) { WAVE_ALLREDUCE(fmaxf) return v; }
__device__ __forceinline__ float half_max(float v) { const auto r = __builtin_amdgcn_permlane32_swap(__float_as_uint(v), __float_as_uint(v), false, false); return fmaxf(__uint_as_float(r[0]), __uint_as_float(r[1])); }
__device__ __forceinline__ float half_sum(float v) { const auto r = __builtin_amdgcn_permlane32_swap(__float_as_uint(v), __float_as_uint(v), false, false); return __uint_as_float(r[0]) + __uint_as_float(r[1]); }
__device__ __forceinline__ float block_sum256(float v, float* sh) {
    v = wave_sum(v);
    __syncthreads();
    if ((threadIdx.x & 63) == 0) sh[threadIdx.x >> 6] = v;
    __syncthreads();
    return sh[0] + sh[1] + sh[2] + sh[3];
}
__device__ __forceinline__ float silu_f(float v) { return v / (1.f + expf(-v)); }
__device__ __forceinline__ float gelu_tanh(float x) { return 0.5f * x * (1.f + tanhf(0.7978845608028654f * (x + 0.044715f * x * x * x))); }
__device__ __forceinline__ float silu_fast(float v) { return v * __builtin_amdgcn_rcpf(1.f + __builtin_amdgcn_exp2f(-1.4426950408889634f * v)); }
__device__ __forceinline__ float gelu_fast(float x) { const float u = 0.7978845608028654f * (x + 0.044715f * x * x * x); return x * __builtin_amdgcn_rcpf(1.f + __builtin_amdgcn_exp2f(-2.8853900817779268f * u)); }

namespace pg8 {
constexpr int BM = 256, BK = 64, HALF = 128, HTB = HALF * BK * 2, STAGE_BYTES = 8 * HTB, NXCD = 8, WGM = 8;
__host__ __device__ __forceinline__ int lds_byte(int r, int c) { return (r >> 3) * 1024 + (r & 7) * 128 + ((((c >> 3) ^ r) & 7) << 4) + (c & 7) * 2; }
__host__ __device__ __forceinline__ void stage_rc(int b, int& R, int& C) { const int blk = b / 1024, pos = (b % 1024) / 16; R = blk * 8 + (pos >> 3); C = (((pos ^ R) & 7)) * 8; }
__host__ __device__ __forceinline__ int perm32(int rho) { const int n = rho >> 4, i = rho & 15; return 8 * (i >> 2) + 4 * n + (i & 3); }

struct Unit { int z, pm, pn, kq; };
struct Gemm { const bf16_t* A; const bf16_t* Bt; size_t aStrideZ, bStrideZ; const int* ridx; long long ridxStrideZ; long long K; };

struct PlainOrder {
    int nM, nN, nwg, G, c;
    __device__ void init(int nM_, int nN_, int G_, int c_) { nM = nM_; nN = nN_; nwg = nM * nN; G = G_; c = c_; }
    __device__ bool map(long L, Unit& u) const {
        if (L >= nwg) return false;
        int wgid = (int)L; { const int q = nwg / NXCD, r = nwg % NXCD, xcd = wgid % NXCD, off = wgid / NXCD; wgid = (xcd < r ? xcd * (q + 1) : r * (q + 1) + (xcd - r) * q) + off; }
        const int nig = WGM * nN, gid = wgid / nig, fm = gid * WGM, gsz = (nM - fm) < WGM ? (nM - fm) : WGM;
        u.kq = -1; u.z = 0; u.pm = fm + ((wgid % nig) % gsz); u.pn = (wgid % nig) / gsz; return true;
    }
    __device__ bool next(int i, Unit& u) const { return map((long)i * G + c, u); }
};
struct InProj1Order {
    PlainOrder p; int G, c;
    __device__ void init(int G_, int c_) { p.init(64, 24, G_, c_); G = G_; c = c_; }
    __device__ bool next(int i, Unit& u) const {
        const long L = (long)i * G + c;
        if (L < 1536) return p.map(L, u);
        const int r = (int)(L - 1536); if (r >= 24) return false;
        u.kq = -1; u.z = 0; u.pm = 64 + r / 12; u.pn = 4 + r % 12; return true;
    }
};
struct L0NormOrder {
    PlainOrder p;
    __device__ void init(int G_, int c_) { p.init(66, 6, G_, c_); }
    __device__ bool next(int i, Unit& u) const { if (!p.next(i, u)) return false; if (u.pn >= 4) u.pn += 2; return true; }
};
struct L0SwapOrder {
    int G, c;
    __device__ void init(int G_, int c_) { G = G_; c = G_ - 1 - c_; }
    __device__ bool next(int i, Unit& u) const { const int L = i * G + c; if (L >= 4 * 66) return false; const int wi = L / 66; u.kq = -1; u.z = 0; u.pm = wi < 2 ? 4 + wi : 6 + wi; u.pn = L % 66; return true; }
};
struct L1NormOrder {
    PlainOrder p;
    __device__ void init(int G_, int c_) { p.init(64, 12, G_, c_); }
    __device__ bool next(int i, Unit& u) const { if (!p.next(i, u)) return false; if (u.pn >= 4) u.pn += 12; return true; }
};
struct SwapOrder {
    int wt0, nTok, tok0, total, G, c;
    __device__ void init(int wt0_, int nWT_, int tok0_, int nTok_, int G_, int c_) { wt0 = wt0_; nTok = nTok_; tok0 = tok0_; total = nWT_ * nTok_; G = G_; c = c_; }
    __device__ bool next(int i, Unit& u) const { const int L = i * G + c; if (L >= total) return false; u.kq = -1; u.z = 0; u.pm = wt0 + L / nTok; u.pn = tok0 + L % nTok; return true; }
};
struct GroupedOrder {
    int nM, nN, GP, G, c;
    __device__ void init(int nM_, int nN_, int GP_, int G_, int c_) { nM = nM_; nN = nN_; GP = GP_; G = G_; c = c_; }
    __device__ bool next(int i, Unit& u) const {
        const int x = c & 7, j = (c >> 3) + i * (G >> 3), per = nM * nN;
        if (j >= 2 * per) return false;
        const int el = j / per, rem = j % per, grp = rem / (nM * GP), w = rem % (nM * GP);
        u.kq = -1; u.z = 2 * x + el; u.pm = w % nM; u.pn = grp * GP + w / nM; return true;
    }
};

struct DnSplitOrder {
    int G, c;
    __device__ void init(int G_, int c_) { G = G_; c = c_; }
    __device__ bool next(int i, Unit& u) const {
        const int x = c & 7, j = (c >> 3) + i * (G >> 3);
        if (j < 64) { u.kq = -1; u.z = 2 * x + (j >> 5); u.pm = j & 7; u.pn = (j & 31) >> 3; return true; }
        if (j >= 96) return false;
        const int s = j - 64; u.kq = s & 3; u.z = 2 * x + (s >> 4); u.pm = 8; u.pn = (s & 15) >> 2; return true;
    }
};
__device__ __forceinline__ u32x4 pack8(const f32x4 a, const f32x4 b) { u32x4 w; w.x = cvt_pk_bf16(a[0], a[1]); w.y = cvt_pk_bf16(a[2], a[3]); w.z = cvt_pk_bf16(b[0], b[1]); w.w = cvt_pk_bf16(b[2], b[3]); return w; }

struct EpiZ0 {
    static constexpr bool PERM = true, FUSED = false;
    bf16_t* QN; bf16_t* KN; bf16_t* U;
    __device__ __forceinline__ void operator()(const f32x4 (&acc)[2][2][4][2], const Unit& u, int wr, int wc, int fr, int fq) const {
        const int row0 = u.pm * BM + wr * 64 + fr;
        if (u.pn >= 6) {
            const int col0 = (u.pn - 6) * BM + wc * 32 + 8 * fq;
#pragma unroll
            for (int ai = 0; ai < 2; ++ai)
#pragma unroll
                for (int m = 0; m < 4; ++m) { bf16_t* rowp = U + (size_t)(row0 + ai * HALF + m * 16) * 512 + col0;
#pragma unroll
                    for (int bj = 0; bj < 2; ++bj) { f32x4 v0 = acc[ai][bj][m][0], v1 = acc[ai][bj][m][1];
#pragma unroll
                        for (int j = 0; j < 4; ++j) { v0[j] = gelu_fast(v0[j]); v1[j] = gelu_fast(v1[j]); }
                        *(u32x4*)(rowp + bj * HALF) = pack8(v0, v1); } }
        } else {
            bf16_t* O = u.pn < 2 ? QN : KN; const int cb = (u.pn & 1) * BM + wc * 32 + 8 * fq;
#pragma unroll
            for (int ai = 0; ai < 2; ++ai)
#pragma unroll
                for (int m = 0; m < 4; ++m) { const int tok = row0 + ai * HALF + m * 16;
#pragma unroll
                    for (int bj = 0; bj < 2; ++bj) { const int c = cb + bj * HALF, head = c >> 6, d0 = c & 63;
                        *(u32x4*)(O + ((((size_t)(tok >> 5) * 8 + head) * 4 + (d0 >> 4)) * 64 + 32 * ((d0 >> 3) & 1) + (tok & 31)) * 8) = pack8(acc[ai][bj][m][0], acc[ai][bj][m][1]); } }
        }
    }
};
struct EpiL0Swap {
    static constexpr bool PERM = true, FUSED = false;
    bf16_t* VN; bf16_t* GVT;
    __device__ __forceinline__ void operator()(const f32x4 (&acc)[2][2][4][2], const Unit& u, int wr, int wc, int fr, int fq) const {
        const int col0 = u.pn * BM + wc * 32 + 8 * fq;
        if (u.pm >= 8) {
            const int rb = (u.pm - 8) * BM + wr * 64 + fr;
#pragma unroll
            for (int ai = 0; ai < 2; ++ai)
#pragma unroll
                for (int m = 0; m < 4; ++m)
#pragma unroll
                    for (int bj = 0; bj < 2; ++bj) { f32x4 v0 = acc[ai][bj][m][0], v1 = acc[ai][bj][m][1];
#pragma unroll
                        for (int j = 0; j < 4; ++j) { v0[j] = gelu_fast(v0[j]); v1[j] = gelu_fast(v1[j]); }
                        *(u32x4*)(GVT + (size_t)(rb + ai * HALF + m * 16) * MT + col0 + bj * HALF) = pack8(v0, v1); }
        } else {
#pragma unroll
            for (int ai = 0; ai < 2; ++ai)
#pragma unroll
                for (int m = 0; m < 4; ++m) { const int c = (u.pm - 4) * BM + ai * HALF + wr * 64 + m * 16 + fr, head = c >> 6, d = c & 63;
#pragma unroll
                    for (int bj = 0; bj < 2; ++bj) { const int T0 = col0 + bj * HALF;
                        const u32x4 w8 = pack8(acc[ai][bj][m][0], acc[ai][bj][m][1]);
                        bf16_t* base = VN + (((((size_t)(T0 >> 5) * 8 + head) * 2 + (d >> 5)) * 2 + ((T0 >> 4) & 1)) * 64 + (d & 31)) * 8 + 4 * ((T0 >> 3) & 1);
                        *(u32x2*)(base) = (u32x2){w8.x, w8.y};
                        *(u32x2*)(base + 32 * 8) = (u32x2){w8.z, w8.w}; } }
        }
    }
};
template <bool SRC_BF16> struct EpiRes {
    static constexpr bool PERM = true, FUSED = false;
    bf16_t* X; const float* srcL; const float* srcC; const float* gate;
    __device__ __forceinline__ void operator()(const f32x4 (&acc)[2][2][4][2], const Unit& u, int wr, int wc, int fr, int fq) const {
        const int row0 = u.pm * BM + wr * 64 + fr, col0 = u.pn * BM + wc * 32 + 8 * fq;
        const float* gp = gate + (u.pm < 64 ? u.pm / 32 : 2) * MODW + col0;
        const float* sp = u.pm < 64 ? srcL + (size_t)row0 * D + col0 : srcC + (size_t)(row0 - ML) * D + col0;
        f32x4 gv[2][2];
#pragma unroll
        for (int bj = 0; bj < 2; ++bj)
#pragma unroll
            for (int n = 0; n < 2; ++n) gv[bj][n] = *(const f32x4*)(gp + bj * HALF + 4 * n);
#pragma unroll
        for (int ai = 0; ai < 2; ++ai)
#pragma unroll
            for (int m = 0; m < 4; ++m) { const size_t ro = (size_t)(ai * HALF + m * 16) * D; bf16_t* rowp = X + (size_t)row0 * D + col0 + ro;
#pragma unroll
                for (int bj = 0; bj < 2; ++bj) { f32x4 s0, s1;
                    if (SRC_BF16) { const u32x4 xb = *(const u32x4*)(rowp + bj * HALF);
                        s0 = (f32x4){__uint_as_float(xb.x << 16), __uint_as_float(xb.x & 0xffff0000u), __uint_as_float(xb.y << 16), __uint_as_float(xb.y & 0xffff0000u)};
                        s1 = (f32x4){__uint_as_float(xb.z << 16), __uint_as_float(xb.z & 0xffff0000u), __uint_as_float(xb.w << 16), __uint_as_float(xb.w & 0xffff0000u)}; }
                    else { s0 = __builtin_nontemporal_load((const f32x4*)(sp + ro + bj * HALF)); s1 = __builtin_nontemporal_load((const f32x4*)(sp + ro + bj * HALF + 4)); }
                    *(u32x4*)(rowp + bj * HALF) = pack8(s0 + gv[bj][0] * acc[ai][bj][m][0], s1 + gv[bj][1] * acc[ai][bj][m][1]); } }
    }
};
struct EpiL1In {
    static constexpr bool PERM = true, FUSED = false;
    bf16_t* Q; bf16_t* Kb; bf16_t* V; bf16_t* Gs; const f32x2* rope;
    __device__ __forceinline__ void operator()(const f32x4 (&acc)[2][2][4][2], const Unit& u, int wr, int wc, int fr, int fq) const {
        const int row0 = u.pm * BM + wr * 64 + fr, cl = wc * 32 + 8 * fq;
        if (u.pn < 8) {
            const bool isq = u.pn < 4; const int head = isq ? u.pn : u.pn - 4; bf16_t* O = isq ? Q : Kb; const float sc = isq ? 1.f : 0.0625f;
            const bool lat = u.pm < 64;
#pragma unroll
            for (int ai = 0; ai < 2; ++ai)
#pragma unroll
                for (int m = 0; m < 4; ++m) {
                    const int row = row0 + ai * HALF + m * 16; const int t = row & (SEQ - 1);
                    const int pos = wc < 2 ? (t >> 6) : (t & 63);
                    const f32x4* tp = (const f32x4*)(rope + pos * 64 + (wc & 1) * 32 + 8 * fq);
                    f32x4 o1[2], o2[2];
#pragma unroll
                    for (int n = 0; n < 2; ++n) {
                        const f32x4 x1 = acc[ai][0][m][n], x2 = acc[ai][1][m][n];
                        if (lat) { const f32x4 cs0 = tp[2 * n], cs1 = tp[2 * n + 1];
                            o1[n][0] = (x1[0] * cs0[0] - x2[0] * cs0[1]) * sc; o2[n][0] = (x1[0] * cs0[1] + x2[0] * cs0[0]) * sc;
                            o1[n][1] = (x1[1] * cs0[2] - x2[1] * cs0[3]) * sc; o2[n][1] = (x1[1] * cs0[3] + x2[1] * cs0[2]) * sc;
                            o1[n][2] = (x1[2] * cs1[0] - x2[2] * cs1[1]) * sc; o2[n][2] = (x1[2] * cs1[1] + x2[2] * cs1[0]) * sc;
                            o1[n][3] = (x1[3] * cs1[2] - x2[3] * cs1[3]) * sc; o2[n][3] = (x1[3] * cs1[3] + x2[3] * cs1[2]) * sc;
                        } else { o1[n] = x1 * sc; o2[n] = x2 * sc; }
                    }
                    bf16_t* fp = O + ((((size_t)(row >> 13) * 4 + head) * 512 + (t >> 4)) * 8 + wc) * 512 + ((t & 15) + 16 * fq) * 8;
                    *(u32x4*)(fp) = pack8(o1[0], o1[1]);
                    *(u32x4*)(fp + 4 * 512) = pack8(o2[0], o2[1]);
                }
        } else {
            const bool isv = u.pn < 16; bf16_t* O = isv ? V : Gs; const int ct = (isv ? u.pn - 8 : u.pn - 16) * BM + cl;
#pragma unroll
            for (int ai = 0; ai < 2; ++ai)
#pragma unroll
                for (int m = 0; m < 4; ++m) { bf16_t* rowp = O + (size_t)(row0 + ai * HALF + m * 16) * 2048 + ct;
#pragma unroll
                    for (int bj = 0; bj < 2; ++bj) { f32x4 v0 = acc[ai][bj][m][0], v1 = acc[ai][bj][m][1];
                        if (!isv) {
#pragma unroll
                            for (int j = 0; j < 4; ++j) { v0[j] = silu_fast(v0[j]); v1[j] = silu_fast(v1[j]); } }
                        if (isv) *(u32x4*)(rowp + bj * HALF) = pack8(v0, v1); else __builtin_nontemporal_store(pack8(v0, v1), (u32x4*)(rowp + bj * HALF)); } }
        }
    }
};
struct EpiL1Swap {
    static constexpr bool PERM = true, FUSED = false;
    bf16_t* KT; bf16_t* VT; const f32x2* rope; const f32x2* rope2;
    bf16_t* KF; LAS unsigned char* scr;
    __device__ __forceinline__ void operator()(const f32x4 (&acc)[2][2][4][2], const Unit& u, int wr, int wc, int fr, int fq) const {
        const int col0 = u.pn * BM + wc * 32 + 8 * fq;
        if (u.pm < 8) {
            const int head = u.pm - 4; const bool lat = u.pn < 64;
#pragma unroll
            for (int m = 0; m < 4; ++m) {
                const int f = 16 * m + fr, r1 = head * 256 + wr * 64 + f;
#pragma unroll
                for (int bj = 0; bj < 2; ++bj) {
                    f32x4 o1[2], o2[2];
#pragma unroll
                    for (int n = 0; n < 2; ++n) {
                        const f32x4 x1 = acc[0][bj][m][n], x2 = acc[1][bj][m][n];
                        if (lat) {
                            f32x4 cc, ss;
                            if (wr == 0) { const int pos = ((u.pn * BM + bj * HALF + wc * 32) & (SEQ - 1)) >> 6; const f32x2 cs = rope[pos * 64 + f];
                                cc = (f32x4){cs.x, cs.x, cs.x, cs.x}; ss = (f32x4){cs.y, cs.y, cs.y, cs.y}; }
                            else { const f32x4* tp = (const f32x4*)(rope2 + f * 128 + (wc & 1) * 32 + 8 * fq + 4 * n); const f32x4 a = tp[0], b = tp[1];
                                cc = (f32x4){a[0], a[2], b[0], b[2]}; ss = (f32x4){a[1], a[3], b[1], b[3]}; }
                            o1[n] = (x1 * cc - x2 * ss) * 0.0625f; o2[n] = (x1 * ss + x2 * cc) * 0.0625f;
                        } else { o1[n] = x1 * 0.0625f; o2[n] = x2 * 0.0625f; }
                    }
                    const int dk = wr * 64 + f; bf16_t* fp = KT + ((((size_t)head * 132 + 2 * u.pn + bj) * 8 + (dk >> 5)) * 8 + 2 * wc + (fq >> 1)) * 512 + (32 * (fq & 1) + (dk & 31)) * 8;
                    *(u32x4*)(fp) = pack8(o1[0], o1[1]);
                    *(u32x4*)(fp + (size_t)4 * 8 * 512) = pack8(o2[0], o2[1]);
                    if (lat) {
                        LAS bf16_t* tl = (LAS bf16_t*)(scr + (wr * 4 + wc) * 2048);
                        *(LAS u32x4*)(tl + fr * 32 + 8 * fq) = pack8(o1[0], o1[1]);
                        *(LAS u32x4*)(tl + 512 + fr * 32 + 8 * fq) = pack8(o2[0], o2[1]);
                        asm volatile("s_waitcnt lgkmcnt(0)" ::: "memory");
                        const int L = fr + 16 * fq, tt = L & 31, hf = L >> 5, T = u.pn * BM + bj * HALF + wc * 32 + tt, t = T & (SEQ - 1);
#pragma unroll
                        for (int part = 0; part < 2; ++part) { const LAS bf16_t* sp = tl + part * 512 + (hf * 8) * 32 + tt; u32x4 w8;
                            w8.x = (unsigned)sp[0] | ((unsigned)sp[32] << 16); w8.y = (unsigned)sp[64] | ((unsigned)sp[96] << 16); w8.z = (unsigned)sp[128] | ((unsigned)sp[160] << 16); w8.w = (unsigned)sp[192] | ((unsigned)sp[224] << 16);
                            const int dk0 = wr * 64 + 16 * m + 8 * hf + 128 * part;
                            *(u32x4*)(KF + ((((size_t)(T >> 13) * 4 + head) * 512 + (t >> 4)) * 8 + (dk0 >> 5)) * 512 + ((t & 15) + 16 * ((dk0 >> 3) & 3)) * 8) = w8; }
                        asm volatile("s_waitcnt lgkmcnt(0)" ::: "memory");
                    }
                }
            }
        } else {
            const int rb = (u.pm - 8) * BM + wr * 64 + fr;
#pragma unroll
            for (int ai = 0; ai < 2; ++ai)
#pragma unroll
                for (int m = 0; m < 4; ++m)
#pragma unroll
                    for (int bj = 0; bj < 2; ++bj) *(u32x4*)(VT + (size_t)(rb + ai * HALF + m * 16) * MT + col0 + bj * HALF) = pack8(acc[ai][bj][m][0], acc[ai][bj][m][1]);
        }
    }
};
struct EpiGU {
    static constexpr bool PERM = true, FUSED = false;
    bf16_t* HID;
    __device__ __forceinline__ void operator()(const f32x4 (&acc)[2][2][4][2], const Unit& u, int wr, int wc, int fr, int fq) const {
        const int row0 = u.pm * BM + wr * 64 + fr, col0 = u.pn * HALF + wc * 32 + 8 * fq;
        bf16_t* base = HID + (size_t)u.z * MEXP * FF;
#pragma unroll
        for (int ai = 0; ai < 2; ++ai)
#pragma unroll
            for (int m = 0; m < 4; ++m) { f32x4 h[2];
#pragma unroll
                for (int n = 0; n < 2; ++n)
#pragma unroll
                    for (int j = 0; j < 4; ++j) h[n][j] = silu_fast(acc[ai][0][m][n][j]) * acc[ai][1][m][n][j];
                const int row = row0 + ai * HALF + m * 16;
                *(u32x4*)(base + ((size_t)(row >> 7) * (FF / 64) + (col0 >> 6)) * 8192 + (row & 127) * 64 + (col0 & 63)) = pack8(h[0], h[1]); }
    }
};
struct EpiDown {
    static constexpr bool PERM = true, FUSED = false;
    bf16_t* YE; const float* gateval;
    __device__ __forceinline__ void operator()(const f32x4 (&acc)[2][2][4][2], const Unit& u, int wr, int wc, int fr, int fq) const {
        const int row0 = u.pm * BM + wr * 64 + fr, col0 = u.pn * BM + wc * 32 + 8 * fq;
        bf16_t* base = YE + (size_t)u.z * MEXP * D; const float* gvp = gateval + u.z * MEXP;
        if (u.kq >= 0) {
            if (wr == 0) {
#pragma unroll
                for (int m = 0; m < 4; ++m) { const int row = row0 + m * 16; const float gsc = gvp[row];
#pragma unroll
                    for (int bj = 0; bj < 2; ++bj) *(u32x4*)(base + (size_t)(row + 64 * u.kq) * D + col0 + bj * HALF) = pack8(acc[0][bj][m][0] * gsc, acc[0][bj][m][1] * gsc); }
            }
            return;
        }
#pragma unroll
        for (int ai = 0; ai < 2; ++ai)
#pragma unroll
            for (int m = 0; m < 4; ++m) { const int row = row0 + ai * HALF + m * 16; const float gsc = gvp[row];
#pragma unroll
                for (int bj = 0; bj < 2; ++bj) *(u32x4*)(base + (size_t)row * D + col0 + bj * HALF) = pack8(acc[ai][bj][m][0] * gsc, acc[ai][bj][m][1] * gsc); }
    }
};

template <class Epi, class Sched, bool GATHER, int SHORT_PM = 1 << 30, bool SPLITK = false, int TILED = 2>
__device__ __forceinline__ void gemm_phase(LAS unsigned char* lds, LAS int* idxl, const Gemm g, const Sched& S, const Epi& E) {
    const int tid = tidx(), wid = __builtin_amdgcn_readfirstlane(tid >> 6), lane = tid & 63, wr = wid >> 2, wc = wid & 3, fr = lane & 15, fq = lane >> 4;
    const int K = (int)g.K, ntf = K / BK;
    int sR[2], sC[2]; unsigned voffB[2], voffA[2][2], voffN[2][2];
#pragma unroll
    for (int i = 0; i < 2; ++i) { stage_rc(tid * 16 + i * 8192, sR[i], sC[i]); const int Rb = Epi::PERM ? ((sR[i] & ~31) + perm32(sR[i] & 31)) : sR[i];
        voffB[i] = (TILED & 2) ? (unsigned)(Rb * BK + sC[i]) * 2u : (unsigned)(Rb * K + sC[i]) * 2u; }
    constexpr size_t kstepA = (TILED & 1) ? (size_t)HALF * BK * 2 : (size_t)(BK * 2), kstepB = (TILED & 2) ? (size_t)HALF * BK * 2 : (size_t)(BK * 2);
    const size_t hstep = (size_t)HALF * K * 2;
    const size_t tstep = 2 * hstep;
    const unsigned ldsw = (unsigned)wid * 1024u;
    const int aoff = lds_byte(wr * 64 + fr, fq * 8), boff = lds_byte(wc * 32 + fr, fq * 8);
#define PG8_SA(b, h) (((b) * 2 + (h)) * HTB)
#define PG8_SB(b, h) ((4 + (b) * 2 + (h)) * HTB)
#define PG8_STAGE(bufoff, gbase, voff) do { _Pragma("unroll") for (int _i = 0; _i < 2; ++_i) \
        __builtin_amdgcn_global_load_lds((const unsigned*)((const char*)(gbase) + (voff)[_i]), (LAS unsigned*)(lds + (bufoff) + ldsw + _i * 8192), 16, 0, 0); } while (0)
#define PG8_LDA(dst, b, h) do { _Pragma("unroll") for (int m = 0; m < 4; ++m) _Pragma("unroll") for (int k = 0; k < 2; ++k) dst[m][k] = *(const LAS bf16x8*)(lds + PG8_SA(b, h) + ((aoff ^ (k * 64)) + m * 2048)); } while (0)
#define PG8_LDB(dst, b, h) do { _Pragma("unroll") for (int n = 0; n < 2; ++n) _Pragma("unroll") for (int k = 0; k < 2; ++k) dst[n][k] = *(const LAS bf16x8*)(lds + PG8_SB(b, h) + ((boff ^ (k * 64)) + n * 2048)); } while (0)
#define PG8_MMA(ai, bj, At, Bt) do { __builtin_amdgcn_s_setprio(1); _Pragma("unroll") for (int m = 0; m < 4; ++m) _Pragma("unroll") for (int n = 0; n < 2; ++n) _Pragma("unroll") for (int k = 0; k < 2; ++k) \
        acc[ai][bj][m][n] = __builtin_amdgcn_mfma_f32_16x16x32_bf16(Bt[n][k], At[m][k], acc[ai][bj][m][n], 0, 0, 0); __builtin_amdgcn_s_setprio(0); } while (0)
#define PG8_WAIT_V(n) asm volatile("s_waitcnt vmcnt(" #n ")" ::: "memory")
#define PG8_WAIT_L(n) asm volatile("s_waitcnt lgkmcnt(" #n ")" ::: "memory")
#define PG8_BAR __builtin_amdgcn_s_barrier()
#define PG8_SCHED __builtin_amdgcn_sched_barrier(0)
    Unit cur, nxt; int ui = 0;
    if (!S.next(0, cur)) return;
    if constexpr (GATHER) {
        for (int k = tid >> 8;; k += 2) { Unit u; if (!S.next(k, u)) break; idxl[k * 256 + (tid & 255)] = g.ridx[(size_t)u.z * g.ridxStrideZ + u.pm * BM + (tid & 255)]; }
        __syncthreads();
#pragma unroll
        for (int hh = 0; hh < 2; ++hh)
#pragma unroll
            for (int i = 0; i < 2; ++i) voffA[hh][i] = (unsigned)idxl[hh * HALF + sR[i]] * (unsigned)(K * 2) + (unsigned)sC[i] * 2u;
    } else {
#pragma unroll
        for (int hh = 0; hh < 2; ++hh)
#pragma unroll
            for (int i = 0; i < 2; ++i) voffA[hh][i] = (TILED & 1) ? (unsigned)hh * (unsigned)(HALF * K * 2) + (unsigned)(sR[i] * BK + sC[i]) * 2u : (unsigned)((hh * HALF + sR[i]) * K + sC[i]) * 2u;
    }
#pragma unroll
    for (int hh = 0; hh < 2; ++hh)
#pragma unroll
        for (int i = 0; i < 2; ++i) voffN[hh][i] = voffA[hh][i];
    f32x4 acc[2][2][4][2];
#pragma unroll
    for (int a = 0; a < 2; ++a)
#pragma unroll
        for (int b = 0; b < 2; ++b)
#pragma unroll
            for (int m = 0; m < 4; ++m)
#pragma unroll
                for (int n = 0; n < 2; ++n) acc[a][b][m][n] = (f32x4){0.f, 0.f, 0.f, 0.f};
    bf16x8 At[4][2], B0[2][2], B1[2][2];
    auto k0t = [&](const Unit& u) -> size_t { return (SPLITK && u.kq >= 0) ? (size_t)(12 * u.kq - (u.kq == 3 ? 2 : 0)) : (size_t)0; };
    const char* cA = (const char*)(g.A + (size_t)cur.z * g.aStrideZ) + (GATHER ? (size_t)0 : (size_t)cur.pm * tstep) + k0t(cur) * kstepA;
    const char* cB = (const char*)(g.Bt + (size_t)cur.z * g.bStrideZ) + (size_t)cur.pn * tstep + k0t(cur) * kstepB;
    PG8_STAGE(PG8_SB(0, 0), cB, voffB); PG8_STAGE(PG8_SB(0, 1), cB + hstep, voffB); PG8_STAGE(PG8_SA(0, 0), cA, voffA[0]); PG8_STAGE(PG8_SA(0, 1), cA, voffA[1]);
    if (wr == 1) PG8_BAR;
    PG8_WAIT_V(2); PG8_BAR;
    PG8_STAGE(PG8_SB(1, 0), cB + kstepB, voffB); PG8_STAGE(PG8_SA(1, 0), cA + kstepA, voffA[0]); PG8_STAGE(PG8_SB(1, 1), cB + hstep + kstepB, voffB);
    PG8_WAIT_V(6); PG8_BAR;
    for (;;) {
        const bool has_next = S.next(ui + 1, nxt);
        const char* nA = has_next ? (const char*)(g.A + (size_t)nxt.z * g.aStrideZ) + (GATHER ? (size_t)0 : (size_t)nxt.pm * tstep) + k0t(nxt) * kstepA : cA;
        const char* nB = has_next ? (const char*)(g.Bt + (size_t)nxt.z * g.bStrideZ) + (size_t)nxt.pn * tstep + k0t(nxt) * kstepB : cB;
        const int nt = (SPLITK && cur.kq >= 0) ? (cur.kq < 2 ? 12 : 10) : ntf;
        const bool shortu = cur.pm >= SHORT_PM, do0 = !shortu || wr == 0, do1 = !shortu;
        for (int t = 0; t < nt; t += 2) {
            const bool last = (t == nt - 2);
            const char* a1 = cA + (size_t)(t + 1) * kstepA;
            const char* a2 = last ? nA : cA + (size_t)(t + 2) * kstepA; const char* b2 = last ? nB : cB + (size_t)(t + 2) * kstepB;
            const char* a3 = a2 + kstepA; const char* b3 = b2 + kstepB;
            unsigned vs[2][2];
            if constexpr (GATHER) {
                if (last && has_next) {
#pragma unroll
                    for (int hh = 0; hh < 2; ++hh)
#pragma unroll
                        for (int i = 0; i < 2; ++i) voffN[hh][i] = (unsigned)idxl[(ui + 1) * 256 + hh * HALF + sR[i]] * (unsigned)(K * 2) + (unsigned)sC[i] * 2u;
                }
#pragma unroll
                for (int hh = 0; hh < 2; ++hh)
#pragma unroll
                    for (int i = 0; i < 2; ++i) vs[hh][i] = last ? voffN[hh][i] : voffA[hh][i];
            } else {
#pragma unroll
                for (int hh = 0; hh < 2; ++hh)
#pragma unroll
                    for (int i = 0; i < 2; ++i) vs[hh][i] = voffA[hh][i];
            }
            PG8_LDB(B0, 0, 0); PG8_LDB(B1, 0, 1); PG8_SCHED; PG8_LDA(At, 0, 0); PG8_STAGE(PG8_SA(1, 1), a1, voffA[1]);
            PG8_WAIT_V(8); PG8_WAIT_L(0); PG8_BAR; if (do0) { PG8_MMA(0, 0, At, B0); PG8_MMA(0, 1, At, B1); } PG8_BAR; PG8_SCHED;
            PG8_LDA(At, 0, 1); PG8_STAGE(PG8_SB(0, 0), b2, voffB); PG8_STAGE(PG8_SB(0, 1), b2 + hstep, voffB); PG8_STAGE(PG8_SA(0, 0), a2, vs[0]);
            PG8_WAIT_V(8); PG8_WAIT_L(0); PG8_BAR; if (do1) { PG8_MMA(1, 0, At, B0); PG8_MMA(1, 1, At, B1); } PG8_BAR; PG8_SCHED;
            PG8_LDB(B0, 1, 0); PG8_LDB(B1, 1, 1); PG8_SCHED; PG8_LDA(At, 1, 0); PG8_STAGE(PG8_SA(0, 1), a2, vs[1]);
            PG8_WAIT_V(8); PG8_WAIT_L(0); PG8_BAR; if (do0) { PG8_MMA(0, 0, At, B0); PG8_MMA(0, 1, At, B1); } PG8_BAR; PG8_SCHED;
            PG8_LDA(At, 1, 1); PG8_STAGE(PG8_SB(1, 0), b3, voffB); PG8_STAGE(PG8_SB(1, 1), b3 + hstep, voffB); PG8_STAGE(PG8_SA(1, 0), a3, vs[0]);
            PG8_WAIT_V(8); PG8_WAIT_L(0); PG8_BAR; if (do1) { PG8_MMA(1, 0, At, B0); PG8_MMA(1, 1, At, B1); } PG8_BAR; PG8_SCHED;
        }
        if (wr == 0) PG8_BAR;
        if constexpr (Epi::FUSED) E.fused(acc, cur, wr, wc, fr, fq, lds, tid); else E(acc, cur, wr, wc, fr, fq);
        if (!has_next) break;
#pragma unroll
        for (int a = 0; a < 2; ++a)
#pragma unroll
            for (int b = 0; b < 2; ++b)
#pragma unroll
                for (int m = 0; m < 4; ++m)
#pragma unroll
                    for (int n = 0; n < 2; ++n) acc[a][b][m][n] = (f32x4){0.f, 0.f, 0.f, 0.f};
        cur = nxt; cA = nA; cB = nB; ++ui;
#pragma unroll
        for (int hh = 0; hh < 2; ++hh)
#pragma unroll
            for (int i = 0; i < 2; ++i) voffA[hh][i] = voffN[hh][i];
        if (wr == 1) PG8_BAR;
    }
    PG8_WAIT_V(0);
    PG8_BAR;
#undef PG8_SA
#undef PG8_SB
#undef PG8_STAGE
#undef PG8_LDA
#undef PG8_LDB
#undef PG8_MMA
#undef PG8_WAIT_V
#undef PG8_WAIT_L
#undef PG8_BAR
#undef PG8_SCHED
}
}

constexpr int CVT_SCR = 16640;
__device__ __forceinline__ void cvt_item(const float* W, int K, int N, bf16_t* WT, int drow0, int k0, int n0, LAS float* scr, int lane) {
    f32x4 v[16];
    const int lr = lane >> 4, lc4 = (lane & 15) * 4;
#pragma unroll
    for (int i = 0; i < 16; ++i) v[i] = __builtin_nontemporal_load((const f32x4*)(W + (size_t)(k0 + 4 * i + lr) * N + n0 + lc4));
#pragma unroll
    for (int i = 0; i < 16; ++i) { LAS float* d = scr + (4 * i + lr) * 65 + lc4; d[0] = v[i][0]; d[1] = v[i][1]; d[2] = v[i][2]; d[3] = v[i][3]; }
    asm volatile("s_waitcnt lgkmcnt(0)" ::: "memory");
    const int c = lane & 7;
#pragma unroll
    for (int j = 0; j < 8; ++j) { const int n = (lane >> 3) + 8 * j; const LAS float* s = scr + (8 * c) * 65 + n;
        u32x4 o; o.x = cvt_pk_bf16(s[0 * 65], s[1 * 65]); o.y = cvt_pk_bf16(s[2 * 65], s[3 * 65]); o.z = cvt_pk_bf16(s[4 * 65], s[5 * 65]); o.w = cvt_pk_bf16(s[6 * 65], s[7 * 65]);
        __builtin_nontemporal_store(o, (u32x4*)(WT + ((size_t)((drow0 + n) >> 7) * (K >> 6) + (k0 >> 6)) * 8192 + ((drow0 + n) & 127) * 64 + 8 * c)); }
    asm volatile("s_waitcnt lgkmcnt(0)" ::: "memory");
}
__device__ __forceinline__ void cvt_plain(const float* W, int K, int N, bf16_t* WT, int item, LAS float* scr, int lane) {
    const int nblk = N / 64, kb = item / nblk, nb = item % nblk;
    cvt_item(W, K, N, WT, nb * 64, kb * 64, nb * 64, scr, lane);
}

struct CvtDense { const float *win0, *wout0, *win1, *wout1; bf16_t *win0t, *wout0t, *win1t, *wout1t; };
__device__ __forceinline__ void phase_cvt_dense(LAS unsigned char* lds, const CvtDense a) {
    const int tid_ = tidx(), wave = tid_ >> 6, lane = tid_ & 63;
    LAS float* scr = (LAS float*)(lds + wave * CVT_SCR);
    const int gw = blockIdx.x * 8 + wave, NGW = gridDim.x * 8;
    constexpr int I0 = (D / 64) * (ABIN / 64), I1 = (D / 64) * (D / 64), I2 = (D / 64) * (RIN / 64), I3 = (2048 / 64) * (D / 64);
    for (int it = gw; it < I0 + I1 + I2 + I3; it += NGW) {
        int r = it;
        if (r < I0) { cvt_plain(a.win0, D, ABIN, a.win0t, r, scr, lane); continue; } r -= I0;
        if (r < I1) { cvt_plain(a.wout0, D, D, a.wout0t, r, scr, lane); continue; } r -= I1;
        if (r < I2) { cvt_plain(a.win1, D, RIN, a.win1t, r, scr, lane); continue; } r -= I2;
        cvt_plain(a.wout1, 2048, D, a.wout1t, r, scr, lane);
    }
}
struct CvtMoe { const float *wg, *wu, *wd; bf16_t *gu, *dn; };
__device__ __forceinline__ void phase_cvt_moe(LAS unsigned char* lds, const CvtMoe a) {
    const int tid_ = tidx(), wave = tid_ >> 6, lane = tid_ & 63;
    LAS float* scr = (LAS float*)(lds + wave * CVT_SCR);
    const int gw = blockIdx.x * 8 + wave, NGW = gridDim.x * 8;
    constexpr int IG = (D / 64) * (FF / 64), ID = (FF / 64) * (D / 64);
    for (int it = gw; it < 2 * NE * (2 * IG + ID); it += NGW) {
        const int e = it / (2 * IG + ID); int r = it % (2 * IG + ID);
        if (r < 2 * IG) { const int up = r / IG; r %= IG; const int nblk = FF / 64, kb = r / nblk, nb = r % nblk, n0 = nb * 64;
            cvt_item((up ? a.wu : a.wg) + (size_t)e * D * FF, D, FF, a.gu + (size_t)e * 2 * FF * D, (n0 / 128) * 256 + up * 128 + (n0 % 128), kb * 64, n0, scr, lane); }
        else { r -= 2 * IG; const int nblk = D / 64, kb = r / nblk, nb = r % nblk; cvt_item(a.wd + (size_t)e * FF * D, FF, D, a.dn + (size_t)e * D * FF, nb * 64, kb * 64, nb * 64, scr, lane); }
    }
}

#define XB_TMO      128
#define XB_XCNT(j)  (256  + 64 * (j))
#define XB_XSUB(j)  (1280 + 64 * (j))
#define XB_XGEN(j)  (2304 + 64 * (j))
#define XB_TOP      3328
#define XB_TOPGEN   3392
#define XCD_BAR_WORDS 3456
#define XB_SPIN_CAP (1u << 18)

__device__ __forceinline__ unsigned xb_ld(unsigned* p)              { return __hip_atomic_load(p, __ATOMIC_RELAXED, __HIP_MEMORY_SCOPE_AGENT); }
__device__ __forceinline__ unsigned xb_add(unsigned* p, unsigned v) { return __hip_atomic_fetch_add(p, v, __ATOMIC_RELAXED, __HIP_MEMORY_SCOPE_AGENT); }
__device__ __forceinline__ unsigned xb_xcc_id() { return (unsigned)__builtin_amdgcn_s_getreg((3 << 11) | 20) & 0xFu; }
#define XB_SPIN(cond, bar) do { unsigned _sp = 0; while (cond) { __builtin_amdgcn_s_sleep(1); \
    if ((++_sp & 255u) == 0u) { if (xb_ld(&(bar)[XB_TMO])) break; if (_sp > XB_SPIN_CAP) { atomicAdd(&(bar)[XB_TMO], 1u); break; } } } } while (0)

struct XcdBarrier { unsigned* bar; unsigned x; volatile LAS unsigned* st; };

__device__ __forceinline__ XcdBarrier xcd_barrier_post(unsigned* bar, volatile LAS unsigned* st) {
    XcdBarrier b; b.bar = bar; b.x = xb_xcc_id(); b.st = st;
    if (threadIdx.x == 0) (void)xb_add(&bar[XB_XCNT(b.x)], 1u);
    return b;
}
__device__ __forceinline__ void xcd_barrier_complete(unsigned* bar, unsigned x, unsigned& nloc, unsigned& nx) {
    const unsigned G = gridDim.x * gridDim.y * gridDim.z;
    unsigned sum, cnt, mine, sp = 0u;
    for (;;) {
        sum = 0u; cnt = 0u; mine = 0u;
#pragma unroll
        for (unsigned j = 0; j < 16; ++j) { const unsigned c = xb_ld(&bar[XB_XCNT(j)]); sum += c; cnt += (c > 0u) ? 1u : 0u; mine = (j == x) ? c : mine; }
        if (sum == G) break;
        __builtin_amdgcn_s_sleep(1);
        if ((++sp & 255u) == 0u) { if (xb_ld(&bar[XB_TMO])) break; if (sp > XB_SPIN_CAP) { atomicAdd(&bar[XB_TMO], 1u); break; } }
    }
    nloc = mine > 0u ? mine : 1u; nx = cnt > 0u ? cnt : 1u;
}
__device__ __forceinline__ void xcd_barrier(const XcdBarrier& b) {
    asm volatile("s_waitcnt vmcnt(0)" ::: "memory");
    __syncthreads();
    if (threadIdx.x == 0) {
        unsigned* bar = b.bar;
        __builtin_amdgcn_s_waitcnt(0);
        unsigned nloc = b.st[0], nx = b.st[1];
        if (nloc == 0u) { xcd_barrier_complete(bar, b.x, nloc, nx); b.st[0] = nloc; b.st[1] = nx; }
        const unsigned old = xb_add(&bar[XB_XSUB(b.x)], 1u);
        const unsigned gen = old / nloc;
        if (old + 1u == (gen + 1u) * nloc) {
            __builtin_amdgcn_fence(__ATOMIC_RELEASE, "agent");
            asm volatile("s_waitcnt vmcnt(0)" ::: "memory");
            const unsigned og = xb_add(&bar[XB_TOP], 1u);
            const unsigned tg = og / nx;
            if (og + 1u == (tg + 1u) * nx) xb_add(&bar[XB_TOPGEN], 1u);
            else XB_SPIN(xb_ld(&bar[XB_TOPGEN]) == tg, bar);
            __builtin_amdgcn_fence(__ATOMIC_ACQUIRE, "agent");
            xb_add(&bar[XB_XGEN(b.x)], 1u);
            asm volatile("s_waitcnt vmcnt(0)" ::: "memory");
        } else {
            XB_SPIN(xb_ld(&bar[XB_XGEN(b.x)]) == gen, bar);
            __builtin_amdgcn_fence(__ATOMIC_ACQUIRE, "agent");
            asm volatile("s_waitcnt vmcnt(0)" ::: "memory");
        }
    }
    __syncthreads();
}

constexpr size_t GUT_L = (size_t)NE * 2 * FF * D, DNT_L = (size_t)NE * D * FF;
constexpr size_t al256(size_t b) { return (b + 255) & ~(size_t)255; }
constexpr size_t OFF_BAR = 0;
constexpr size_t OFF_PCNT = OFF_BAR + al256((size_t)3456 * 4);
constexpr size_t ZERO_BYTES = (OFF_PCNT - OFF_BAR) + (size_t)2 * 128 * 256;
constexpr size_t OFF_X = OFF_BAR + al256(ZERO_BYTES);
constexpr size_t OFF_HB = OFF_X + al256((size_t)MT * D * 4);
constexpr size_t OFF_R2 = OFF_HB + al256((size_t)MT * D * 2);
constexpr size_t OFF_VN = OFF_R2 + al256((size_t)NE * MEXP * FF * 2);
constexpr size_t OFF_ABB = OFF_VN + al256((size_t)MT * 512 * 4);
constexpr size_t OFF_A2B = OFF_ABB + al256((size_t)MT * D * 2);
constexpr size_t OFF_YEB = OFF_A2B + al256((size_t)ML * 2048 * 2);
constexpr size_t OFF_O = OFF_YEB + al256((size_t)NE * MEXP * D * 2);
constexpr size_t OFF_WIN0 = OFF_O + al256((size_t)2 * ML * 2048 * 4);
constexpr size_t OFF_WOUT0 = OFF_WIN0 + al256((size_t)ABIN * D * 2);
constexpr size_t OFF_WIN1 = OFF_WOUT0 + al256((size_t)D * D * 2);
constexpr size_t OFF_WOUT1 = OFF_WIN1 + al256((size_t)RIN * D * 2);
constexpr size_t OFF_GUT = OFF_WOUT1 + al256((size_t)D * 2048 * 2);
constexpr size_t OFF_DNT = OFF_GUT + al256(2 * GUT_L * 2);
constexpr size_t OFF_MOD = OFF_DNT + al256(2 * DNT_L * 2);
constexpr size_t OFF_AFFL = OFF_MOD + al256((size_t)2 * 3 * MODW * 4);
constexpr size_t OFF_AFFC = OFF_AFFL + al256((size_t)NB * NE * SEQ * 4);
constexpr size_t OFF_GATE = OFF_AFFC + al256((size_t)NB * NE * CTX * 4);
constexpr size_t OFF_RIDX = OFF_GATE + al256((size_t)NE * MEXP * 4);
constexpr size_t OFF_SLOT = OFF_RIDX + al256((size_t)NE * MEXP * 4);
constexpr size_t OFF_ROPE = OFF_SLOT + al256((size_t)MT * 16 * 4);
constexpr size_t OFF_ROPE2 = OFF_ROPE + al256((size_t)128 * 64 * 8);
constexpr size_t OFF_SGW = OFF_ROPE2 + al256((size_t)64 * 128 * 8);
constexpr size_t WS_END = OFF_SGW + al256((size_t)8 * 128 * 128 * 2);
constexpr size_t R2_Q = OFF_R2, R2_KN = R2_Q + (size_t)ML * 1024 * 2, R2_KT = R2_KN + (size_t)ML * 1024 * 2, R2_VT = R2_KT + (size_t)1024 * MT * 2;
static_assert(R2_VT + (size_t)2048 * MT * 2 <= OFF_VN, "R2 map");
constexpr size_t R2_QK0 = OFF_R2, R2_U0 = R2_QK0 + (size_t)MT * 1024 * 2, R2_VT0 = R2_U0 + (size_t)MT * 512 * 2, R2_GVT0 = R2_VT0 + (size_t)512 * MT * 2;
constexpr size_t O_OB = OFF_O, O_ATT = O_OB + (size_t)2 * ML * 2048 * 2, O_GS = O_ATT + (size_t)2 * 2 * 4 * 64 * 128 * 128 * 2;
static_assert(O_GS + (size_t)ML * 2048 * 2 <= OFF_WIN0, "O map");
struct Params {
    const float *x, *c, *ctx, *c_ctx, *ada_w, *ada_b, *norm1_g, *norm2_g, *ab_w_in, *ab_w_out, *na_rpb, *sgu_norm_g, *sgu_w, *sgu_b,
                *ret_w_in, *ret_w_out, *ret_decay, *moe_router, *moe_w_gate, *moe_w_up, *moe_w_down, *final_g;
    float* out; char* ws;
};
#define WSP(T, off) ((T*)(p.ws + (off)))

__device__ __forceinline__ float fq_sum(float s) {
    { const auto r = __builtin_amdgcn_permlane16_swap(__float_as_uint(s), __float_as_uint(s), false, false); s = __uint_as_float(r[0]) + __uint_as_float(r[1]); }
    { const auto r = __builtin_amdgcn_permlane32_swap(__float_as_uint(s), __float_as_uint(s), false, false); s = __uint_as_float(r[0]) + __uint_as_float(r[1]); }
    return s;
}
template <int LAYER> struct EpiResNorm {
    static constexpr bool PERM = true, FUSED = true;
    char* ws; const float* g2; const float* wrt; const float* srcL; const float* srcC;
    __device__ __forceinline__ void fused(f32x4 (&acc)[2][2][4][2], const pg8::Unit& u_, int wr_, int wc_, int fr_, int fq_, LAS unsigned char* lds, int tid_) const {
        int wr = wr_, wc = wc_, fr = fr_, fq = fq_, tid = tid_; asm volatile("" : "+s"(wr), "+s"(wc), "+v"(fr), "+v"(fq), "+v"(tid));
        using pg8::BM; using pg8::HALF; using pg8::pack8;
        pg8::Unit u = u_; asm volatile("" : "+s"(u.pm), "+s"(u.pn));
        bf16_t* X = (bf16_t*)(ws + OFF_X); bf16_t* HB = (bf16_t*)(ws + OFF_HB); const float* mod = (const float*)(ws + OFF_MOD) + LAYER * 3 * MODW; const float* gate = mod + 2 * D;
        float* xbuf = (float*)(ws + OFF_VN) + (1u << 18); unsigned* cnt = (unsigned*)(ws + OFF_PCNT) + LAYER * 128 * 64;
        const bool isctx = u.pm >= 64;
        const int wid = __builtin_amdgcn_readfirstlane(tid >> 6), lane = tid & 63;
        const int row0 = u.pm * BM + wr * 64 + fr, col0 = u.pn * BM + wc * 32 + 8 * fq, bidx = isctx ? 2 : u.pm / 32;
        {   const float* gp = gate + bidx * MODW + col0; f32x4 gv[2][2];
#pragma unroll
            for (int bj = 0; bj < 2; ++bj)
#pragma unroll
                for (int n = 0; n < 2; ++n) gv[bj][n] = *(const f32x4*)(gp + bj * HALF + 4 * n);
#pragma unroll
            for (int ai = 0; ai < 2; ++ai)
#pragma unroll
                for (int m = 0; m < 4; ++m) { bf16_t* rowp = X + (size_t)(row0 + ai * HALF + m * 16) * D + col0;
#pragma unroll
                    for (int bj = 0; bj < 2; ++bj) { f32x4 s0, s1;
                        if (LAYER == 0) { const float* sp = (isctx ? srcC + (size_t)(row0 - ML + ai * HALF + m * 16) * D : srcL + (size_t)(row0 + ai * HALF + m * 16) * D) + col0 + bj * HALF;
                            s0 = __builtin_nontemporal_load((const f32x4*)sp); s1 = __builtin_nontemporal_load((const f32x4*)(sp + 4)); }
                        else { const u32x4 xb = *(const u32x4*)(rowp + bj * HALF);
                            s0 = (f32x4){__uint_as_float(xb.x << 16), __uint_as_float(xb.x & 0xffff0000u), __uint_as_float(xb.y << 16), __uint_as_float(xb.y & 0xffff0000u)};
                            s1 = (f32x4){__uint_as_float(xb.z << 16), __uint_as_float(xb.z & 0xffff0000u), __uint_as_float(xb.w << 16), __uint_as_float(xb.w & 0xffff0000u)}; }
                        const u32x4 w = pack8(s0 + gv[bj][0] * acc[ai][bj][m][0], s1 + gv[bj][1] * acc[ai][bj][m][1]);
                        *(u32x4*)(rowp + bj * HALF) = w;
                        acc[ai][bj][m][0] = (f32x4){__uint_as_float(w.x << 16), __uint_as_float(w.x & 0xffff0000u), __uint_as_float(w.y << 16), __uint_as_float(w.y & 0xffff0000u)};
                        acc[ai][bj][m][1] = (f32x4){__uint_as_float(w.z << 16), __uint_as_float(w.z & 0xffff0000u), __uint_as_float(w.w << 16), __uint_as_float(w.w & 0xffff0000u)}; } }
        }
        asm volatile("s_waitcnt vmcnt(0)" ::: "memory"); __builtin_amdgcn_s_barrier(); asm volatile("" ::: "memory");
        LAS bf16_t* WLh = (LAS bf16_t*)lds;
        LAS bf16_t* WLl = WLh + 16 * 264;
        LAS float* CSH = (LAS float*)(WLl + 16 * 264);
        LAS float* P = CSH + 64;
        LAS float* Sr = P + 256 * 4 * 20;
        LAS float* LG = Sr + 256;
        LAS unsigned* flag = (LAS unsigned*)(LG + 1024);
        const float* mrow = mod + bidx * MODW;
        for (int idx = tid; idx < 4096; idx += NTHR) { const int e = idx & 15, c = idx >> 4, cg = u.pn * BM + c; const float wv = wrt[cg * 16 + e] * g2[cg] * (mrow[4 * D + cg] + 1.f);
            const bf16_t hi = f2bf(wv); WLh[e * 264 + c] = hi; WLl[e * 264 + c] = f2bf(wv - bf2f(hi)); }
        {
            const int e = tid & 15, cp = tid >> 4; float s = 0.f;
#pragma unroll 8
            for (int k = 0; k < 32; ++k) { const int c = cp * 32 + k; s += mrow[3 * D + c] * wrt[c * 16 + e]; }
            Sr[cp * 16 + e] = s;
        }
        asm volatile("s_waitcnt lgkmcnt(0)" ::: "memory"); __builtin_amdgcn_s_barrier(); asm volatile("" ::: "memory");
        if (tid < 16) { float s = 0.f;
#pragma unroll
            for (int q = 0; q < 32; ++q) s += Sr[q * 16 + tid];
            CSH[tid] = s; }
        {   bf16x8 Ah[2], Al[2];
#pragma unroll
            for (int bj = 0; bj < 2; ++bj) { Ah[bj] = *(const LAS bf16x8*)(WLh + fr * 264 + bj * HALF + wc * 32 + 8 * fq); Al[bj] = *(const LAS bf16x8*)(WLl + fr * 264 + bj * HALF + wc * 32 + 8 * fq); }
#pragma unroll
            for (int ai = 0; ai < 2; ++ai)
#pragma unroll
                for (int m = 0; m < 4; ++m) { float s = 0.f; f32x4 pe = {0.f, 0.f, 0.f, 0.f};
#pragma unroll
                    for (int bj = 0; bj < 2; ++bj) {
#pragma unroll
                        for (int n = 0; n < 2; ++n) { const f32x4 x = acc[ai][bj][m][n]; s += (x[0] * x[0] + x[1] * x[1]) + (x[2] * x[2] + x[3] * x[3]); }
                        const bf16x8 xb = __builtin_bit_cast(bf16x8, pack8(acc[ai][bj][m][0], acc[ai][bj][m][1]));
                        pe = __builtin_amdgcn_mfma_f32_16x16x32_bf16(Ah[bj], xb, pe, 0, 0, 0); pe = __builtin_amdgcn_mfma_f32_16x16x32_bf16(Al[bj], xb, pe, 0, 0, 0); }
                    s = fq_sum(s);
                    LAS float* pr = P + ((ai * HALF + wr * 64 + m * 16 + fr) * 4 + wc) * 20;
                    *(LAS f32x4*)(pr + 4 * fq) = pe;
                    if (fq == 0) pr[16] = s; }
        }
        asm volatile("s_waitcnt lgkmcnt(0)" ::: "memory"); __builtin_amdgcn_s_barrier(); asm volatile("" ::: "memory");
        float* slot = xbuf + ((size_t)u.pm * BM * 4 + u.pn) * 20;
        for (int idx = tid; idx < 256 * 17; idx += NTHR) { const int row = idx / 17, k = idx - row * 17;
            const float s = (P[(row * 4 + 0) * 20 + k] + P[(row * 4 + 1) * 20 + k]) + (P[(row * 4 + 2) * 20 + k] + P[(row * 4 + 3) * 20 + k]);
            __hip_atomic_store(slot + (size_t)row * 80 + k, s, __ATOMIC_RELAXED, __HIP_MEMORY_SCOPE_AGENT); }
        asm volatile("s_waitcnt vmcnt(0)" ::: "memory");
        if (lane == 0) __hip_atomic_fetch_add(cnt + 64 * u.pm, 1u, __ATOMIC_RELAXED, __HIP_MEMORY_SCOPE_AGENT);
        if (wid == 0) { bool dead = false; unsigned sp = 0u;
            for (;;) { if ((unsigned)__builtin_amdgcn_readfirstlane(__hip_atomic_load(cnt + 64 * u.pm, __ATOMIC_RELAXED, __HIP_MEMORY_SCOPE_AGENT)) >= 32u) break;
                if (++sp > (1u << 22)) { dead = true; break; }
                __builtin_amdgcn_s_sleep(2); }
            __builtin_amdgcn_fence(__ATOMIC_ACQUIRE, "agent");
            if (lane == 0) flag[0] = dead ? 1u : 0u; }
        asm volatile("s_waitcnt vmcnt(0) lgkmcnt(0)" ::: "memory"); __builtin_amdgcn_s_barrier(); asm volatile("" ::: "memory");
        const bool bad = flag[0] != 0u;
        const float* pan = xbuf + (size_t)u.pm * BM * 80;
        if (tid < 256) { const float* sl = pan + (size_t)tid * 80 + 16;
            const float ss = (__hip_atomic_load(sl, __ATOMIC_RELAXED, __HIP_MEMORY_SCOPE_AGENT) + __hip_atomic_load(sl + 20, __ATOMIC_RELAXED, __HIP_MEMORY_SCOPE_AGENT))
                           + (__hip_atomic_load(sl + 40, __ATOMIC_RELAXED, __HIP_MEMORY_SCOPE_AGENT) + __hip_atomic_load(sl + 60, __ATOMIC_RELAXED, __HIP_MEMORY_SCOPE_AGENT));
            Sr[tid] = rsqrtf(ss * (1.f / D) + EPS); }
        asm volatile("s_waitcnt lgkmcnt(0)" ::: "memory"); __builtin_amdgcn_s_barrier(); asm volatile("" ::: "memory");
#pragma unroll
        for (int q = 0; q < 2; ++q) { const int item = tid + q * NTHR, rl = item >> 4, e = item & 15, row = 64 * u.pn + rl; const float* sl = pan + (size_t)row * 80 + e;
            const float s = (__hip_atomic_load(sl, __ATOMIC_RELAXED, __HIP_MEMORY_SCOPE_AGENT) + __hip_atomic_load(sl + 20, __ATOMIC_RELAXED, __HIP_MEMORY_SCOPE_AGENT))
                          + (__hip_atomic_load(sl + 40, __ATOMIC_RELAXED, __HIP_MEMORY_SCOPE_AGENT) + __hip_atomic_load(sl + 60, __ATOMIC_RELAXED, __HIP_MEMORY_SCOPE_AGENT));
            LG[rl * 16 + e] = Sr[row] * s + CSH[e]; }
        asm volatile("s_waitcnt lgkmcnt(0)" ::: "memory"); __builtin_amdgcn_s_barrier(); asm volatile("" ::: "memory");
        if (tid < 64) { float a[16]; float mx = -3.0e38f;
#pragma unroll
            for (int e = 0; e < 16; ++e) { a[e] = LG[tid * 16 + e]; mx = fmaxf(mx, a[e]); }
            float sum = 0.f;
#pragma unroll
            for (int e = 0; e < 16; ++e) { a[e] = expf(a[e] - mx); sum += a[e]; }
            const float inv = 1.f / sum; const int row = u.pm * BM + 64 * u.pn + tid;
            float* ap = isctx ? (float*)(ws + OFF_AFFC) + (size_t)((row - ML) / CTX) * 16 * CTX + (row - ML) % CTX : (float*)(ws + OFF_AFFL) + (size_t)(row / SEQ) * 16 * SEQ + row % SEQ;
            const int es = isctx ? CTX : SEQ;
#pragma unroll
            for (int e = 0; e < 16; ++e) ap[(size_t)e * es] = bad ? __builtin_nanf("") : a[e] * inv; }
#pragma unroll
        for (int bj = 0; bj < 2; ++bj) { f32x4 G[2], SH[2];
#pragma unroll
            for (int n = 0; n < 2; ++n) { const int c = col0 + bj * HALF + 4 * n; const f32x4 gg = *(const f32x4*)(g2 + c), sc = *(const f32x4*)(mrow + 4 * D + c);
                G[n] = gg * (sc + 1.f); SH[n] = *(const f32x4*)(mrow + 3 * D + c); }
#pragma unroll
            for (int ai = 0; ai < 2; ++ai)
#pragma unroll
                for (int m = 0; m < 4; ++m) { const int rl = ai * HALF + wr * 64 + m * 16 + fr; const float r = bad ? __builtin_nanf("") : Sr[rl];
                    *(u32x4*)(HB + (size_t)(u.pm * BM + rl) * D + col0 + bj * HALF) = pack8(acc[ai][bj][m][0] * r * G[0] + SH[0], acc[ai][bj][m][1] * r * G[1] + SH[1]); }
            asm volatile("" ::: "memory"); }
    }
    __device__ __forceinline__ void operator()(const f32x4 (&)[2][2][4][2], const pg8::Unit&, int, int, int, int) const {}
};


__device__ __forceinline__ void lds_fence() { asm volatile("s_waitcnt lgkmcnt(0)" ::: "memory"); }

__device__ __forceinline__ void ph_prologue(const int vc, const Params& p, LAS unsigned char* lds) {
    const int tid = tidx(), wave = tid >> 6, lane = tid & 63;
    if (blockIdx.x < 192) {
        LAS float* s = (LAS float*)(lds + LDS_STAGE); LAS float* red = (LAS float*)(lds + LDS_STAGE + 12288);
        const int layer = blockIdx.x / 96, n0 = (blockIdx.x % 96) * 64;
        for (int i = tid; i < 3072; i += NTHR) { const int r = i >> 10, k = i & 1023; s[i] = silu_f(r < 2 ? p.c[r * D + k] : p.c_ctx[k]); }
        __syncthreads();
        const float* w = p.ada_w + (size_t)layer * D * MODW + n0 + lane;
        float a0 = 0.f, a1 = 0.f, a2 = 0.f;
#pragma unroll 1
        for (int k0 = wave * 128; k0 < wave * 128 + 128; k0 += 32) {
            float wv[32];
#pragma unroll
            for (int i = 0; i < 32; ++i) wv[i] = __builtin_nontemporal_load(w + (size_t)(k0 + i) * MODW);
#pragma unroll
            for (int i = 0; i < 32; ++i) { a0 += s[k0 + i] * wv[i]; a1 += s[1024 + k0 + i] * wv[i]; a2 += s[2048 + k0 + i] * wv[i]; }
        }
        red[(wave * 3 + 0) * 64 + lane] = a0; red[(wave * 3 + 1) * 64 + lane] = a1; red[(wave * 3 + 2) * 64 + lane] = a2;
        __syncthreads();
        if (tid < 192) { const int r = tid >> 6; float sum = 0.f;
#pragma unroll
            for (int q = 0; q < 8; ++q) sum += red[(q * 3 + r) * 64 + lane];
            WSP(float, OFF_MOD)[((size_t)layer * 3 + r) * MODW + n0 + lane] = sum + p.ada_b[layer * MODW + n0 + lane]; }
        __syncthreads();
    }
    { const int i = blockIdx.x * NTHR + tid;
      if (i < 128 * 64) { const int pos = i >> 6, f = i & 63; const float inv = 1.0f / powf(10000.f, (float)(2 * f) / 128.f); const float ang = (float)pos * inv; const f32x2 cs = (f32x2){cosf(ang), sinf(ang)}; WSP(f32x2, OFF_ROPE)[i] = cs; WSP(f32x2, OFF_ROPE2)[f * 128 + pos] = cs; } }
    for (int i = blockIdx.x * NTHR + tid; i < 8 * 128 * 128; i += gridDim.x * NTHR) { const int g = i >> 14, pp = (i >> 7) & 127, q = i & 127;
        WSP(bf16_t, OFF_SGW)[(((g * 4 + (pp >> 5)) * 8 + (q >> 4)) * 64 + (pp & 31) + 32 * ((q >> 3) & 1)) * 8 + (q & 7)] = f2bf(p.sgu_w[i]); }
    phase_cvt_dense(lds, CvtDense{p.ab_w_in, p.ab_w_out, p.ret_w_in, p.ret_w_out, WSP(bf16_t, OFF_WIN0), WSP(bf16_t, OFF_WOUT0), WSP(bf16_t, OFF_WIN1), WSP(bf16_t, OFF_WOUT1)});
    phase_cvt_moe(lds, CvtMoe{p.moe_w_gate, p.moe_w_up, p.moe_w_down, WSP(bf16_t, OFF_GUT), WSP(bf16_t, OFF_DNT)});
}

__device__ __forceinline__ void row_load(const float* xr, int lane, f32x4 (&v)[4]) {
#pragma unroll
    for (int j = 0; j < 4; ++j) v[j] = ((const f32x4*)xr)[lane + 64 * j];
}
__device__ __forceinline__ void row_load_b(const bf16_t* xr, int lane, f32x4 (&v)[4]) {
#pragma unroll
    for (int j = 0; j < 4; ++j) { const u32x2 y = ((const u32x2*)xr)[lane + 64 * j];
        v[j] = (f32x4){__uint_as_float(y.x << 16), __uint_as_float(y.x & 0xffff0000u), __uint_as_float(y.y << 16), __uint_as_float(y.y & 0xffff0000u)}; }
}
__device__ __forceinline__ void row_store_b(bf16_t* xr, int lane, const f32x4 (&v)[4]) {
#pragma unroll
    for (int j = 0; j < 4; ++j) { u32x2 w; w.x = cvt_pk_bf16(v[j][0], v[j][1]); w.y = cvt_pk_bf16(v[j][2], v[j][3]); ((u32x2*)xr)[lane + 64 * j] = w; }
}
__device__ __forceinline__ float row_rms(const f32x4 (&v)[4]) {
    float ss = 0.f;
#pragma unroll
    for (int j = 0; j < 4; ++j) ss += (v[j][0] * v[j][0] + v[j][1] * v[j][1]) + (v[j][2] * v[j][2] + v[j][3] * v[j][3]);
    return rsqrtf(wave_sum(ss) * (1.f / D) + EPS);
}
__device__ __forceinline__ void row_mod_store(const f32x4 (&v)[4], float r, const float* g, const float* shift, const float* scale, bf16_t* hrow, int lane, f32x4 (&o)[4]) {
#pragma unroll
    for (int j = 0; j < 4; ++j) { const int c4 = lane + 64 * j;
        const f32x4 gg = ((const f32x4*)g)[c4], sc = ((const f32x4*)scale)[c4], sh = ((const f32x4*)shift)[c4];
        o[j] = v[j] * r * gg * (sc + 1.f) + sh;
        u32x2 w; w.x = cvt_pk_bf16(o[j][0], o[j][1]); w.y = cvt_pk_bf16(o[j][2], o[j][3]);
        ((u32x2*)hrow)[c4] = w; }
}

template <bool ROUTER, bool L0SRC>
__device__ __forceinline__ void ph_normmod(const int vc, const Params& p, LAS unsigned char* lds, int layer, int rows, const float* g, int shiftOff, int scaleOff) {
    const int tid = tidx(), wave = tid >> 6, lane = tid & 63;
    const int gw = vc * 8 + wave, NGW = gridDim.x * 8;
    LAS float* wl = (LAS float*)lds;
    if constexpr (ROUTER) {
        const float* wr = p.moe_router + (size_t)layer * D * NE;
        for (int i = tid; i < D * NE; i += NTHR) wl[(i & 15) * D + (i >> 4)] = wr[i];
        __syncthreads();
    }
    const float* modl = WSP(float, OFF_MOD) + (size_t)layer * 3 * MODW;
    f32x4 vn[4];
    auto load_row = [&](int row, f32x4 (&d)[4]) { if (L0SRC) row_load(row < ML ? p.x + (size_t)row * D : p.ctx + (size_t)(row - ML) * D, lane, d); else row_load_b(WSP(bf16_t, OFF_X) + (size_t)row * D, lane, d); };
    if (gw < rows) load_row(gw, vn);
    for (int row = gw; row < rows; row += NGW) {
        f32x4 v[4], o[4];
#pragma unroll
        for (int j = 0; j < 4; ++j) v[j] = vn[j];
        load_row(row + NGW < rows ? row + NGW : row, vn);
        const float r = row_rms(v);
        const float* m = modl + (row < ML ? row / SEQ : 2) * MODW;
        row_mod_store(v, r, g, m + shiftOff, m + scaleOff, WSP(bf16_t, OFF_HB) + (size_t)row * D, lane, o);
        if constexpr (ROUTER) {
            float acc[16];
#pragma unroll
            for (int e = 0; e < 16; ++e) { float a = 0.f;
#pragma unroll
                for (int j = 0; j < 4; ++j) { const f32x4 w4 = *(const LAS f32x4*)(wl + e * D + 4 * lane + 256 * j); a += (o[j][0] * w4[0] + o[j][1] * w4[1]) + (o[j][2] * w4[2] + o[j][3] * w4[3]); }
                acc[e] = a;
                if ((e & 3) == 3) asm volatile("" ::: "memory"); }
            float a8[8], a4[4], a2[2], a1;
            { const bool hi = lane & 32;
#pragma unroll
              for (int i = 0; i < 8; ++i) { const float send = hi ? acc[i] : acc[i + 8], keep = hi ? acc[i + 8] : acc[i]; a8[i] = keep + __shfl_xor(send, 32); } }
            { const bool hi = lane & 16;
#pragma unroll
              for (int i = 0; i < 4; ++i) { const float send = hi ? a8[i] : a8[i + 4], keep = hi ? a8[i + 4] : a8[i]; a4[i] = keep + __shfl_xor(send, 16); } }
            { const bool hi = lane & 8;
#pragma unroll
              for (int i = 0; i < 2; ++i) { const float send = hi ? a4[i] : a4[i + 2], keep = hi ? a4[i + 2] : a4[i]; a2[i] = keep + __shfl_xor(send, 8); } }
            { const bool hi = lane & 4; const float send = hi ? a2[0] : a2[1], keep = hi ? a2[1] : a2[0]; a1 = keep + __shfl_xor(send, 4); }
            a1 += __shfl_xor(a1, 2); a1 += __shfl_xor(a1, 1);
            float mx = a1;
#pragma unroll
            for (int of = 4; of <= 32; of <<= 1) mx = fmaxf(mx, __shfl_xor(mx, of));
            const float ex = expf(a1 - mx); float sum = ex;
#pragma unroll
            for (int of = 4; of <= 32; of <<= 1) sum += __shfl_xor(sum, of);
            const float a = ex / sum;
            if ((lane & 3) == 0) { const int e = lane >> 2;
                if (row < ML) WSP(float, OFF_AFFL)[((size_t)(row / SEQ) * 16 + e) * SEQ + (row % SEQ)] = a;
                else WSP(float, OFF_AFFC)[((size_t)((row - ML) / CTX) * 16 + e) * CTX + ((row - ML) % CTX)] = a; }
        }
    }
}

template <int VPT>
__device__ __forceinline__ void topk_list(const Params& p, LAS unsigned char* lds, const float* a, int N, int cap, int rowbase, int mbase, int e) {
    const int tid = tidx(), wave = tid >> 6, lane = tid & 63;
    LAS unsigned* hist = (LAS unsigned*)lds; LAS unsigned* sc = hist + 256; LAS unsigned* wsum = hist + 272;
    const bool active = tid * VPT < N;
    unsigned k[VPT];
#pragma unroll
    for (int j = 0; j < VPT; ++j) k[j] = active ? __float_as_uint(a[tid * VPT + j]) << 2 : 0u;
    unsigned prefix = 0u, mask = 0u; int need = cap;
#pragma unroll 1
    for (int pass = 0; pass < 4; ++pass) {
        const int shift = 24 - 8 * pass;
        if (tid < 256) hist[tid] = 0u;
        __syncthreads();
        if (active) {
#pragma unroll
            for (int j = 0; j < VPT; ++j) if ((k[j] & mask) == prefix) __hip_atomic_fetch_add(&hist[(k[j] >> shift) & 255u], 1u, __ATOMIC_RELAXED, __HIP_MEMORY_SCOPE_WORKGROUP);
        }
        __syncthreads();
        if (wave == 0) {
            const int c0 = hist[4 * lane], c1 = hist[4 * lane + 1], c2 = hist[4 * lane + 2], c3 = hist[4 * lane + 3], tot = c0 + c1 + c2 + c3;
            int incl = tot;
#pragma unroll
            for (int of = 1; of < 64; of <<= 1) { const int t = __shfl_down(incl, of); if (lane + of < 64) incl += t; }
            const int excl = incl - tot;
            if (excl < need && need <= incl) {
                int rem = need - excl, d;
                if (rem <= c3) d = 3; else { rem -= c3; if (rem <= c2) d = 2; else { rem -= c2; if (rem <= c1) d = 1; else { rem -= c1; d = 0; } } }
                sc[0] = prefix | ((unsigned)(4 * lane + d) << shift); sc[1] = (unsigned)rem;
            }
        }
        __syncthreads();
        prefix = sc[0]; need = (int)sc[1]; mask |= 255u << shift;
        __syncthreads();
    }
    const unsigned T = prefix; const int G = cap - need;
    unsigned cnt = 0u;
#pragma unroll
    for (int j = 0; j < VPT; ++j) if (active) cnt += (k[j] > T ? 1u : 0u) + (k[j] == T ? 0x10000u : 0u);
    unsigned incl = cnt;
#pragma unroll
    for (int of = 1; of < 64; of <<= 1) { const unsigned t = __shfl_up(incl, of); if (lane >= of) incl += t; }
    if (lane == 63) wsum[wave] = incl;
    __syncthreads();
    unsigned base = 0u;
#pragma unroll
    for (int q = 0; q < 8; ++q) if (q < wave) base += wsum[q];
    unsigned run = base + incl - cnt;
    int gtb = (int)(run & 0xffffu), eqb = (int)(run >> 16);
    if (active) {
#pragma unroll
        for (int j = 0; j < VPT; ++j) {
            const int i = tid * VPT + j, row = rowbase + i; int slot = -1;
            if (k[j] > T) slot = gtb++;
            else if (k[j] == T) { if (eqb < need) slot = G + eqb; ++eqb; }
            if (slot >= 0) { const int m = mbase + slot; WSP(int, OFF_RIDX)[e * MEXP + m] = row; WSP(float, OFF_GATE)[e * MEXP + m] = __uint_as_float(k[j] >> 2); WSP(int, OFF_SLOT)[row * 16 + e] = m; }
            else WSP(int, OFF_SLOT)[row * 16 + e] = -1;
        }
    }
    __syncthreads();
}
__device__ __forceinline__ void ph_topk(const int vc, const Params& p, LAS unsigned char* lds, bool with_ctx) {
    const int nitems = with_ctx ? 64 : 32;
    for (int it = vc; it < nitems; it += gridDim.x) {
        if (it < 32) { const int b = it >> 4, e = it & 15;
            topk_list<16>(p, lds, WSP(float, OFF_AFFL) + ((size_t)b * 16 + e) * SEQ, SEQ, CAPL, b * SEQ, b * CAPL, e);
            if (b == 0) { const int from = with_ctx ? 2 * CAPL + 2 * CAPC : 2 * CAPL;
                for (int m = from + tidx(); m < MEXP; m += NTHR) { WSP(int, OFF_RIDX)[e * MEXP + m] = 0; WSP(float, OFF_GATE)[e * MEXP + m] = 0.f; } }
        } else { const int q = it - 32, b = q >> 4, e = q & 15;
            topk_list<1>(p, lds, WSP(float, OFF_AFFC) + ((size_t)b * 16 + e) * CTX, CTX, CAPC, ML + b * CTX, 2 * CAPL + b * CAPC, e); }
    }
}

template <bool LAST>
__device__ __forceinline__ void ph_combine(const int vc, const Params& p, int layer, int rows) {
    const int tid = tidx(), wave = tid >> 6, lane = tid & 63;
    const int gw = vc * 8 + wave, NGW = gridDim.x * 8;
    const float* modl = WSP(float, OFF_MOD) + (size_t)layer * 3 * MODW;
    const float* modn = WSP(float, OFF_MOD) + (size_t)(layer + 1) * 3 * MODW;
    u32x2 xn[4]; int son = -1;
    auto prefetch = [&](int row) { const bf16_t* xr = WSP(bf16_t, OFF_X) + (size_t)row * D;
#pragma unroll
        for (int j = 0; j < 4; ++j) xn[j] = ((const u32x2*)xr)[lane + 64 * j];
        son = WSP(int, OFF_SLOT)[row * 16 + (lane & 15)]; };
    if (gw < rows) prefetch(gw);
    for (int row = gw; row < rows; row += NGW) {
        f32x4 v[4], acc[4];
#pragma unroll
        for (int j = 0; j < 4; ++j) { v[j] = (f32x4){__uint_as_float(xn[j].x << 16), __uint_as_float(xn[j].x & 0xffff0000u), __uint_as_float(xn[j].y << 16), __uint_as_float(xn[j].y & 0xffff0000u)}; acc[j] = (f32x4){0.f, 0.f, 0.f, 0.f}; }
        const int so = son;
        prefetch(row + NGW < rows ? row + NGW : row);
        auto add_row = [&](const u32x2 (&y)[4]) {
#pragma unroll
            for (int j = 0; j < 4; ++j) { acc[j][0] += __uint_as_float(y[j].x << 16); acc[j][1] += __uint_as_float(y[j].x & 0xffff0000u); acc[j][2] += __uint_as_float(y[j].y << 16); acc[j][3] += __uint_as_float(y[j].y & 0xffff0000u); } };
        if (!LAST && row >= ML) {
#pragma unroll 1
            for (int e = 0; e < 16; ++e) { const int m = __builtin_amdgcn_readlane(so, e);
                if (m >= 0) { const bf16_t* yr = WSP(bf16_t, OFF_YEB) + ((size_t)e * MEXP + m) * D;
#pragma unroll 1
                    for (int pt = 0; pt < 4; ++pt, yr += (size_t)64 * D) { u32x2 y[4];
#pragma unroll
                        for (int j = 0; j < 4; ++j) y[j] = __builtin_nontemporal_load((const u32x2*)yr + lane + 64 * j);
                        add_row(y); } } }
        } else {
            unsigned sel = (unsigned)__builtin_amdgcn_ballot_w64(so >= 0) & 0xffffu;
#pragma unroll 1
            while (sel) {
                const int e0 = __builtin_ctz(sel); sel &= sel - 1u;
                const bool two = sel != 0u; const int e1 = two ? __builtin_ctz(sel) : e0; if (two) sel &= sel - 1u;
                const bf16_t* y0p = WSP(bf16_t, OFF_YEB) + ((size_t)e0 * MEXP + __builtin_amdgcn_readlane(so, e0)) * D;
                const bf16_t* y1p = WSP(bf16_t, OFF_YEB) + ((size_t)e1 * MEXP + __builtin_amdgcn_readlane(so, e1)) * D;
                u32x2 y0[4], y1[4];
#pragma unroll
                for (int j = 0; j < 4; ++j) { y0[j] = __builtin_nontemporal_load((const u32x2*)y0p + lane + 64 * j); y1[j] = __builtin_nontemporal_load((const u32x2*)y1p + lane + 64 * j); }
                add_row(y0); if (two) add_row(y1);
            }
        }
        const float* m = modl + (row < ML ? row / SEQ : 2) * MODW + 5 * D;
#pragma unroll
        for (int j = 0; j < 4; ++j) v[j] = v[j] + ((const f32x4*)m)[lane + 64 * j] * acc[j];
        const float r = row_rms(v);
        if constexpr (LAST) {
#pragma unroll
            for (int j = 0; j < 4; ++j) __builtin_nontemporal_store(v[j] * r * ((const f32x4*)p.final_g)[lane + 64 * j], (f32x4*)(p.out + (size_t)row * D) + lane + 64 * j);
        } else {
            row_store_b(WSP(bf16_t, OFF_X) + (size_t)row * D, lane, v);
            const float* mn = modn + (row < ML ? row / SEQ : 2) * MODW; f32x4 o[4];
            row_mod_store(v, r, p.norm1_g + (layer + 1) * D, mn, mn + D, WSP(bf16_t, OFF_HB) + (size_t)row * D, lane, o);
        }
    }
}

typedef float f32x16 __attribute__((ext_vector_type(16)));
constexpr float NA_NEG = -1.0e30f, NA_C = 0.125f * 1.4426950408889634f;
template <bool NB, int R0, int R1>
__device__ __forceinline__ void na_tile(const f32x16& S, float& m_run, float& l_run, f32x16& O0, f32x16& O1, bf16x8 (&pf)[2], const LAS float* tabp, int mk) {
    float t[16];
    float mx = NA_NEG;
#pragma unroll
    for (int r = R0; r < R1; ++r) { const int kc = (r & 3) + 8 * (r >> 2);
        if (NB) { const float tv = S[r] * NA_C + tabp[kc]; t[r] = ((unsigned)(mk + kc) < 16u) ? tv : NA_NEG; } else t[r] = S[r] * NA_C;
        mx = fmaxf(mx, t[r]); }
    mx = half_max(mx);
    const float m_new = fmaxf(m_run, mx), alpha = __builtin_amdgcn_exp2f(m_run - m_new);
    float ps = 0.f; float pv[16];
#pragma unroll
    for (int r = 0; r < 16; ++r) { if (r >= R0 && r < R1) { pv[r] = __builtin_amdgcn_exp2f(t[r] - m_new); ps += pv[r]; } else pv[r] = 0.f; }
    ps = half_sum(ps);
    l_run = l_run * alpha + ps; m_run = m_new;
#pragma unroll
    for (int r = 0; r < 16; ++r) { O0[r] *= alpha; O1[r] *= alpha; }
#pragma unroll
    for (int s2 = 0; s2 < 2; ++s2) { u32x4 w; w.x = cvt_pk_bf16(pv[8 * s2 + 0], pv[8 * s2 + 1]); w.y = cvt_pk_bf16(pv[8 * s2 + 2], pv[8 * s2 + 3]); w.z = cvt_pk_bf16(pv[8 * s2 + 4], pv[8 * s2 + 5]); w.w = cvt_pk_bf16(pv[8 * s2 + 6], pv[8 * s2 + 7]);
        pf[s2] = __builtin_bit_cast(bf16x8, w); }
}
__device__ __forceinline__ void ph_na2(const int vc, const Params& p, LAS unsigned char* lds) {
    const int tid = tidx(), w = tid >> 6, l = tid & 63, lh = l >> 5, lc = l & 31;
    LAS float* tab = (LAS float*)(lds + w * 8192);
    const bf16_t* QN = WSP(bf16_t, R2_QK0); const bf16_t* KN = QN + (size_t)MT * 512; const bf16_t* VN = WSP(bf16_t, R2_VT0); bf16_t* AB = WSP(bf16_t, OFF_ABB);
    for (int it = vc * 8 + w; it < 2048 + 64; it += gridDim.x * 8) {
        const bool lat = it < 2048;
        int b, h, i = 0, qrow0;
        if (lat) { b = it >> 10; h = (it >> 7) & 7; i = it & 127; qrow0 = b * SEQ + i * 64; }
        else { const int q = it - 2048; b = q >> 5; h = (q >> 2) & 7; qrow0 = ML + b * CTX + (q & 3) * 64; }
        if (lat) {
#pragma unroll
            for (int k = 0; k < 30; ++k) { const int idx = l + 64 * k, r = idx >> 7, dc = (idx & 127) - 63; const bool in = dc >= -15 && dc <= 15;
                tab[idx] = in ? p.na_rpb[(h * 15 + r) * 31 + (in ? dc + 15 : 0)] * 1.4426950408889634f : 0.f; }
            lds_fence(); }
        bf16x8 qf[2][4];
#pragma unroll
        for (int qb = 0; qb < 2; ++qb)
#pragma unroll
            for (int ks = 0; ks < 4; ++ks) qf[qb][ks] = *(const bf16x8*)(QN + ((((size_t)((qrow0 >> 5) + qb) * 8 + h) * 4 + ks) * 64 + l) * 8);
        f32x16 O[2][2];
#pragma unroll
        for (int qb = 0; qb < 2; ++qb)
#pragma unroll
            for (int db = 0; db < 2; ++db)
#pragma unroll
                for (int r = 0; r < 16; ++r) O[qb][db][r] = 0.f;
        float m_run[2] = {NA_NEG, NA_NEG}, l_run[2] = {0.f, 0.f};
        const int r0 = min(max(i - 4, 0), 120);
        const int ntiles = lat ? 24 : 8;
        auto tile_row0 = [&](int tt) -> int { return tt >= 8 ? b * SEQ + (r0 + ((tt - 8) >> 1)) * 64 + 32 * (tt & 1) : ML + b * CTX + 32 * tt; };
        auto load_tile = [&](int krow0, bf16x8 (&kf)[4], bf16x8 (&vf)[2][2]) __attribute__((always_inline)) {
#pragma unroll
            for (int ks = 0; ks < 4; ++ks) kf[ks] = *(const bf16x8*)(KN + ((((size_t)(krow0 >> 5) * 8 + h) * 4 + ks) * 64 + l) * 8);
#pragma unroll
            for (int db = 0; db < 2; ++db)
#pragma unroll
                for (int s2 = 0; s2 < 2; ++s2) vf[db][s2] = *(const bf16x8*)(VN + (((((size_t)(krow0 >> 5) * 8 + h) * 2 + db) * 2 + s2) * 64 + l) * 8);
        };
        bf16x8 kf[4], vf[2][2], kn[4], vn[2][2];
        load_tile(tile_row0(0), kf, vf);
#pragma unroll 1
        for (int tt = 0; tt < ntiles; ++tt) {
            const bool nb = tt >= 8; const int kr = r0 + ((tt - 8) >> 1), half = tt & 1;
            load_tile(tile_row0(tt + 1 < ntiles ? tt + 1 : tt), kn, vn);
            bf16x8 p0[2], p1[2];
            const LAS float* trow = tab + (nb ? (kr - i + 7) * 128 : 0);
            const int cs0 = min(max(lc - 8, 0), 48), cs1 = min(max(lc + 24, 0), 48);
            const LAS float* tp0 = trow + (32 * half + 4 * lh - lc + 63); const LAS float* tp1 = tp0 - 32;
            const int mk0 = 32 * half + 4 * lh - cs0, mk1 = 32 * half + 4 * lh - cs1;
            {   f32x16 S;
#pragma unroll
                for (int r = 0; r < 16; ++r) S[r] = 0.f;
#pragma unroll
                for (int ks = 0; ks < 4; ++ks) S = __builtin_amdgcn_mfma_f32_32x32x16_bf16(kf[ks], qf[0][ks], S, 0, 0, 0);
                if (!nb) na_tile<false, 0, 16>(S, m_run[0], l_run[0], O[0][0], O[0][1], p0, tab, 0);
                else if (half == 0) na_tile<true, 0, 16>(S, m_run[0], l_run[0], O[0][0], O[0][1], p0, tp0, mk0);
                else na_tile<true, 0, 4>(S, m_run[0], l_run[0], O[0][0], O[0][1], p0, tp0, mk0);
            }
            __builtin_amdgcn_sched_barrier(0);
            {   f32x16 S;
#pragma unroll
                for (int r = 0; r < 16; ++r) S[r] = 0.f;
#pragma unroll
                for (int ks = 0; ks < 4; ++ks) S = __builtin_amdgcn_mfma_f32_32x32x16_bf16(kf[ks], qf[1][ks], S, 0, 0, 0);
                if (!nb) na_tile<false, 0, 16>(S, m_run[1], l_run[1], O[1][0], O[1][1], p1, tab, 0);
                else if (half == 0) na_tile<true, 12, 16>(S, m_run[1], l_run[1], O[1][0], O[1][1], p1, tp1, mk1);
                else na_tile<true, 0, 16>(S, m_run[1], l_run[1], O[1][0], O[1][1], p1, tp1, mk1);
            }
            __builtin_amdgcn_sched_barrier(0);
#pragma unroll
            for (int db = 0; db < 2; ++db) {
                if (!nb || half == 0) { O[0][db] = __builtin_amdgcn_mfma_f32_32x32x16_bf16(vf[db][0], p0[0], O[0][db], 0, 0, 0); O[0][db] = __builtin_amdgcn_mfma_f32_32x32x16_bf16(vf[db][1], p0[1], O[0][db], 0, 0, 0); }
                else O[0][db] = __builtin_amdgcn_mfma_f32_32x32x16_bf16(vf[db][0], p0[0], O[0][db], 0, 0, 0);
                if (!nb || half == 1) { O[1][db] = __builtin_amdgcn_mfma_f32_32x32x16_bf16(vf[db][0], p1[0], O[1][db], 0, 0, 0); O[1][db] = __builtin_amdgcn_mfma_f32_32x32x16_bf16(vf[db][1], p1[1], O[1][db], 0, 0, 0); }
                else O[1][db] = __builtin_amdgcn_mfma_f32_32x32x16_bf16(vf[db][1], p1[1], O[1][db], 0, 0, 0);
            }
#pragma unroll
            for (int ks = 0; ks < 4; ++ks) kf[ks] = kn[ks];
#pragma unroll
            for (int db = 0; db < 2; ++db)
#pragma unroll
                for (int s2 = 0; s2 < 2; ++s2) vf[db][s2] = vn[db][s2];
        }
#pragma unroll
        for (int qb = 0; qb < 2; ++qb) { const float inv = 1.f / l_run[qb]; bf16_t* orow = AB + (size_t)(qrow0 + 32 * qb + lc) * D + h * 64 + 4 * lh;
#pragma unroll
            for (int db = 0; db < 2; ++db)
#pragma unroll
                for (int g = 0; g < 4; ++g) { u32x2 wv; wv.x = cvt_pk_bf16(O[qb][db][4 * g] * inv, O[qb][db][4 * g + 1] * inv); wv.y = cvt_pk_bf16(O[qb][db][4 * g + 2] * inv, O[qb][db][4 * g + 3] * inv);
                    *(u32x2*)(orow + 32 * db + 8 * g) = wv; } }
        lds_fence();
    }
}

__device__ __forceinline__ void ph_sgu2(const int vc, const Params& p, LAS unsigned char* lds) {
    const int tid = tidx(), g = tid >> 6, l = tid & 63, lh = l >> 5, lc = l & 31;
    LAS float* part = (LAS float*)(lds + 65536); LAS float* rq = part + 32 * 128;
    const bf16_t* GVT = WSP(bf16_t, R2_GVT0); const bf16_t* U = WSP(bf16_t, R2_U0); const bf16_t* W = WSP(bf16_t, OFF_SGW) + (size_t)g * 16384; bf16_t* AB = WSP(bf16_t, OFF_ABB);
    for (int ch = (int)gridDim.x - 1 - vc; ch < MT / 128; ch += gridDim.x) {
        const int tok0 = ch * 128;
        {
            const int tg = tid & 15, rg = tid >> 4; float ss[8];
#pragma unroll
            for (int j = 0; j < 8; ++j) ss[j] = 0.f;
            const bf16_t* gp = GVT + (size_t)(rg * 16) * MT + tok0 + 8 * tg;
            u32x4 gv[16];
#pragma unroll
            for (int c = 0; c < 16; ++c) gv[c] = *(const u32x4*)(gp + (size_t)c * MT);
#pragma unroll
            for (int c = 0; c < 16; ++c) { const u32x4 v = gv[c];
                const float f0 = __uint_as_float(v.x << 16), f1 = __uint_as_float(v.x & 0xffff0000u), f2 = __uint_as_float(v.y << 16), f3 = __uint_as_float(v.y & 0xffff0000u);
                const float f4 = __uint_as_float(v.z << 16), f5 = __uint_as_float(v.z & 0xffff0000u), f6 = __uint_as_float(v.w << 16), f7 = __uint_as_float(v.w & 0xffff0000u);
                ss[0] += f0 * f0; ss[1] += f1 * f1; ss[2] += f2 * f2; ss[3] += f3 * f3; ss[4] += f4 * f4; ss[5] += f5 * f5; ss[6] += f6 * f6; ss[7] += f7 * f7; }
            *(LAS f32x4*)(part + rg * 128 + 8 * tg) = (f32x4){ss[0], ss[1], ss[2], ss[3]}; *(LAS f32x4*)(part + rg * 128 + 8 * tg + 4) = (f32x4){ss[4], ss[5], ss[6], ss[7]};
            __syncthreads();
            if (tid < 128) { float s = 0.f;
#pragma unroll
                for (int r = 0; r < 32; ++r) s += part[r * 128 + tid];
                rq[tid] = rsqrtf(s * (1.f / 512.f) + EPS); }
            __syncthreads();
        }
        bf16x8 af[2][8];
#pragma unroll
        for (int cb = 0; cb < 2; ++cb)
#pragma unroll
            for (int ks = 0; ks < 8; ++ks) { const u32x4 v = *(const u32x4*)(GVT + (size_t)(g * 64 + 32 * cb + lc) * MT + tok0 + 16 * ks + 8 * lh);
                const f32x4 k0 = *(const LAS f32x4*)(rq + 16 * ks + 8 * lh), k1 = *(const LAS f32x4*)(rq + 16 * ks + 8 * lh + 4);
                u32x4 sv;
                sv.x = cvt_pk_bf16(__uint_as_float(v.x << 16) * k0[0], __uint_as_float(v.x & 0xffff0000u) * k0[1]);
                sv.y = cvt_pk_bf16(__uint_as_float(v.y << 16) * k0[2], __uint_as_float(v.y & 0xffff0000u) * k0[3]);
                sv.z = cvt_pk_bf16(__uint_as_float(v.z << 16) * k1[0], __uint_as_float(v.z & 0xffff0000u) * k1[1]);
                sv.w = cvt_pk_bf16(__uint_as_float(v.w << 16) * k1[2], __uint_as_float(v.w & 0xffff0000u) * k1[3]);
                af[cb][ks] = __builtin_bit_cast(bf16x8, sv); }
#pragma unroll 1
        for (int pb = 0; pb < 4; ++pb) {
            f32x16 C0, C1;
#pragma unroll
            for (int r = 0; r < 16; ++r) { C0[r] = 0.f; C1[r] = 0.f; }
#pragma unroll
            for (int ks = 0; ks < 8; ++ks) { const bf16x8 bw = *(const bf16x8*)(W + (size_t)((pb * 8 + ks) * 64 + l) * 8);
                C0 = __builtin_amdgcn_mfma_f32_32x32x16_bf16(af[0][ks], bw, C0, 0, 0, 0); C1 = __builtin_amdgcn_mfma_f32_32x32x16_bf16(af[1][ks], bw, C1, 0, 0, 0); }
            const int pp = 32 * pb + lc, row = tok0 + pp; const float bias = p.sgu_b[g * 128 + pp];
#pragma unroll
            for (int cb = 0; cb < 2; ++cb)
#pragma unroll
                for (int q4 = 0; q4 < 4; ++q4) { const int c0 = g * 64 + 32 * cb + 8 * q4 + 4 * lh;
                    const u32x2 uu = *(const u32x2*)(U + (size_t)row * 512 + c0); const f32x4 sg = *(const f32x4*)(p.sgu_norm_g + c0);
                    const float u0 = __uint_as_float(uu.x << 16), u1 = __uint_as_float(uu.x & 0xffff0000u), u2 = __uint_as_float(uu.y << 16), u3 = __uint_as_float(uu.y & 0xffff0000u);
                    const f32x16& C = cb ? C1 : C0;
                    u32x2 wv; wv.x = cvt_pk_bf16(u0 * (sg[0] * C[4 * q4] + bias), u1 * (sg[1] * C[4 * q4 + 1] + bias)); wv.y = cvt_pk_bf16(u2 * (sg[2] * C[4 * q4 + 2] + bias), u3 * (sg[3] * C[4 * q4 + 3] + bias));
                    *(u32x2*)(AB + (size_t)row * D + 512 + c0) = wv; }
        }
        __syncthreads();
    }
}

__device__ __forceinline__ float ret_lg2(const Params& p, int dir, int h) { const float xl = p.ret_decay[dir * 4 + h]; return -log1pf(expf(-xl)) * 1.4426950408889634f; }

__device__ __forceinline__ void ph_att(const int vc, const Params& p, LAS unsigned char* lds, const int first) {
    const int tid = tidx(), w = __builtin_amdgcn_readfirstlane(tid >> 6), l = tid & 63, lq = l >> 4, lr = l & 15;
    const bf16_t* Qf = WSP(bf16_t, R2_Q); const bf16_t* Kf = WSP(bf16_t, R2_KN); bf16_t* ATT = WSP(bf16_t, O_ATT);
    const int nw = (int)gridDim.x - first, u0 = vc - first;
    if (u0 < 0) return;
    LAS bf16_t* Kl = (LAS bf16_t*)lds;
    auto stage = [&](int u, int buf) { const int b = u >> 8, h = (u >> 6) & 3, n = u & 63;
        const bf16_t* kg = Kf + ((size_t)((b * 4 + h) * 512 + n * 8) * 8) * 512;
#pragma unroll
        for (int i = 0; i < 8; ++i) __builtin_amdgcn_global_load_lds((const unsigned*)(kg + (size_t)((i * 8 + w) * 512 + l * 8)), (LAS unsigned*)(Kl + buf * 32768 + (i * 8 + w) * 512), 16, 0, 0); };
    if (u0 < 512) stage(u0, 0);
    if (u0 + nw < 512) stage(u0 + nw, 1);
#pragma unroll 1
    for (int j = 0; j < 3; ++j) { const int u = u0 + j * nw; if (u >= 512) break;
        asm volatile("s_waitcnt vmcnt(0)" ::: "memory");
        __syncthreads();
        const int b = u >> 8, h = (u >> 6) & 3, n = u & 63;
        const float lgf = ret_lg2(p, 0, h), lgb = ret_lg2(p, 1, h);
        const bf16_t* qb = Qf + ((size_t)((b * 4 + h) * 512 + n * 8 + w) * 8) * 512 + l * 8;
        const LAS bf16_t* kb = Kl + (j & 1) * 32768 + l * 8;
        bf16x8 qf[8];
#pragma unroll
        for (int ks = 0; ks < 8; ++ks) qf[ks] = *(const bf16x8*)(qb + ks * 512);
        bf16_t* af = ATT + ((size_t)((0 * 2 + b) * 4 + h) * 64 + n) * 16384 + (size_t)w * 4 * 512;
        bf16_t* ab = ATT + ((size_t)((1 * 2 + b) * 4 + h) * 64 + n) * 16384 + (size_t)w * 4 * 512;
        const int t = 16 * w + lr;
#pragma unroll 2
        for (int sb = 0; sb < 8; ++sb) {
            f32x4 c = {0.f, 0.f, 0.f, 0.f};
#pragma unroll
            for (int ks = 0; ks < 8; ++ks) { const bf16x8 kf = *(const LAS bf16x8*)(kb + (sb * 8 + ks) * 512); c = __builtin_amdgcn_mfma_f32_16x16x32_bf16(kf, qf[ks], c, 0, 0, 0); }
            const int s0 = 16 * sb + 4 * lq; float vf[4], vb[4];
#pragma unroll
            for (int r = 0; r < 4; ++r) { const int sx = s0 + r;
                vf[r] = sx <= t ? c[r] * __builtin_amdgcn_exp2f((float)(t - sx) * lgf) : 0.f;
                vb[r] = sx >= t ? c[r] * __builtin_amdgcn_exp2f((float)(sx - t) * lgb) : 0.f; }
            u32x2 wf, wb; wf.x = cvt_pk_bf16(vf[0], vf[1]); wf.y = cvt_pk_bf16(vf[2], vf[3]); wb.x = cvt_pk_bf16(vb[0], vb[1]); wb.y = cvt_pk_bf16(vb[2], vb[3]);
            const int off = (sb >> 1) * 512 + (lr + 16 * (2 * (sb & 1) + (lq >> 1))) * 8 + 4 * (lq & 1);
            *(u32x2*)(af + off) = wf; *(u32x2*)(ab + off) = wb;
        }
        if (j == 0 && u0 + 2 * nw < 512) { __syncthreads(); stage(u0 + 2 * nw, 0); }
    }
}

constexpr int RS_ST = 264, RS_VT = 136;
__device__ __forceinline__ void ph_rscan(const int vc, const Params& p, LAS unsigned char* lds) {
    const int tid = tidx(), w = __builtin_amdgcn_readfirstlane(tid >> 6), l = tid & 63;
    const int c = vc, combo = 2 * (c & 7) + ((c >> 3) >> 4), sl = (c >> 3) & 15;
    if (c >= 256) return;
    const int dir = combo & 1, h = (combo >> 1) & 3, b = combo >> 3;
    const bf16_t* Q = WSP(bf16_t, R2_Q); const bf16_t* KT = WSP(bf16_t, R2_KT); const bf16_t* VT = WSP(bf16_t, R2_VT);
    const bf16_t* ATT = WSP(bf16_t, O_ATT) + (size_t)((dir * 2 + b) * 4 + h) * 64 * 16384;
    bf16_t* Ob = WSP(bf16_t, O_OB) + (size_t)dir * ML * 2048;
    LAS bf16_t* STl = (LAS bf16_t*)lds;
    LAS bf16_t* VTl = (LAS bf16_t*)(lds + 2 * 32 * RS_ST * 2);
    LAS bf16_t* VSl = VTl + 2 * 32 * RS_VT;
    LAS float* kd = (LAS float*)(VSl + 2 * 32 * RS_VT); LAS float* qd = kd + 128;
    const float lg = ret_lg2(p, dir, h);
    if (tid < 128) { kd[tid] = __builtin_amdgcn_exp2f(lg * (float)(dir ? tid : 127 - tid)); qd[tid] = __builtin_amdgcn_exp2f(lg * (float)(dir ? 128 - tid : tid + 1)); }
    const float cd = __builtin_amdgcn_exp2f(lg * 128.f);
    for (int i = tid; i < 32 * RS_ST; i += NTHR) STl[i] = 0;
    __syncthreads();
    auto tokbase = [&](int si) -> int { if (si < 2) { const int cn = dir ? 1 - si : si; return ML + b * CTX + 128 * cn; } const int n = si - 2; return b * SEQ + 128 * (dir ? 63 - n : n); };
    auto chunk_of = [&](int si) -> int { const int n = si - 2; return dir ? 63 - n : n; };
    const int vdv = tid >> 4, vt0 = (tid & 15) * 8;
    const bf16_t* vrow = VT + (size_t)(h * 512 + sl * 32 + vdv) * MT + vt0;
    auto stage_v = [&](u32x4 v, int buf) {
        *(LAS u32x4*)(VTl + (buf * 32 + vdv) * RS_VT + vt0) = v;
        const f32x4 k0 = *(const LAS f32x4*)(kd + vt0), k1 = *(const LAS f32x4*)(kd + vt0 + 4);
        u32x4 s;
        s.x = cvt_pk_bf16(__uint_as_float(v.x << 16) * k0[0], __uint_as_float(v.x & 0xffff0000u) * k0[1]);
        s.y = cvt_pk_bf16(__uint_as_float(v.y << 16) * k0[2], __uint_as_float(v.y & 0xffff0000u) * k0[3]);
        s.z = cvt_pk_bf16(__uint_as_float(v.z << 16) * k1[0], __uint_as_float(v.z & 0xffff0000u) * k1[1]);
        s.w = cvt_pk_bf16(__uint_as_float(v.w << 16) * k1[2], __uint_as_float(v.w & 0xffff0000u) * k1[3]);
        *(LAS u32x4*)(VSl + (buf * 32 + vdv) * RS_VT + vt0) = s;
    };
    f32x16 S;
#pragma unroll
    for (int i = 0; i < 16; ++i) S[i] = 0.f;
    { const u32x4 v0 = *(const u32x4*)(vrow + tokbase(0)); stage_v(v0, 0); }
    bf16x8 qA[8], qB[8], af[4], kf[8];
#pragma unroll
    for (int i = 0; i < 8; ++i) { qA[i] = (bf16x8){0, 0, 0, 0, 0, 0, 0, 0}; qB[i] = qA[i]; }
#pragma unroll
    for (int i = 0; i < 4; ++i) af[i] = (bf16x8){0, 0, 0, 0, 0, 0, 0, 0};
    { const bf16_t* kp = KT + (((size_t)h * 132 + (tokbase(0) >> 7)) * 8 + w) * 8 * 512 + l * 8;
#pragma unroll
      for (int ks = 0; ks < 8; ++ks) kf[ks] = *(const bf16x8*)(kp + ks * 512); }
    auto att_need = [&](int ks) -> bool { return dir ? ks >= (w >> 1) : ks <= ((16 * w + 15) >> 5); };
    constexpr int NSTEP = 66;
    bf16_t* dump = WSP(bf16_t, OFF_VN);
    auto step = [&](const int si, const bf16x8 (&qf)[8], bf16x8 (&qn)[8]) __attribute__((always_inline)) {
        const int cur = si & 1;
        __syncthreads();
        const int sn = si + 1 < NSTEP ? si + 1 : si; const int tbn = tokbase(sn); const int cn = sn < 2 ? (dir ? 63 : 0) : chunk_of(sn);
        const u32x4 vnext = *(const u32x4*)(vrow + tbn);
        { const bf16_t* qp = Q + (((size_t)(b * 4 + h) * 512 + cn * 8 + w) * 8) * 512 + l * 8;
#pragma unroll
          for (int ks = 0; ks < 8; ++ks) qn[ks] = *(const bf16x8*)(qp + ks * 512); }
        f32x4 oi[2], oa[2];
#pragma unroll
        for (int nt = 0; nt < 2; ++nt) { oi[nt] = (f32x4){0.f, 0.f, 0.f, 0.f}; oa[nt] = (f32x4){0.f, 0.f, 0.f, 0.f}; }
        {   bf16x8 bs[16];
#pragma unroll
            for (int ks = 0; ks < 8; ++ks)
#pragma unroll
                for (int nt = 0; nt < 2; ++nt) bs[2 * ks + nt] = *(const LAS bf16x8*)(STl + (cur * 32 + 16 * nt + (l & 15)) * RS_ST + 32 * ks + 8 * (l >> 4));
            __builtin_amdgcn_sched_barrier(0);
#pragma unroll
            for (int ks = 0; ks < 8; ++ks)
#pragma unroll
                for (int nt = 0; nt < 2; ++nt) oi[nt] = __builtin_amdgcn_mfma_f32_16x16x32_bf16(bs[2 * ks + nt], qf[ks], oi[nt], 0, 0, 0);
        }
        __builtin_amdgcn_sched_barrier(0);
        {   bf16x8 bv[8];
#pragma unroll
            for (int ks = 0; ks < 4; ++ks)
#pragma unroll
                for (int nt = 0; nt < 2; ++nt) bv[2 * ks + nt] = *(const LAS bf16x8*)(VTl + (cur * 32 + 16 * nt + (l & 15)) * RS_VT + 32 * ks + 8 * (l >> 4));
            __builtin_amdgcn_sched_barrier(0);
#pragma unroll
            for (int ks = 0; ks < 4; ++ks) if (att_need(ks)) {
#pragma unroll
                for (int nt = 0; nt < 2; ++nt) oa[nt] = __builtin_amdgcn_mfma_f32_16x16x32_bf16(bv[2 * ks + nt], af[ks], oa[nt], 0, 0, 0); }
        }
        __builtin_amdgcn_sched_barrier(0);
        { const bf16_t* apn = ATT + (size_t)cn * 16384 + (size_t)w * 4 * 512 + l * 8;
#pragma unroll
          for (int ks = 0; ks < 4; ++ks) { const int kse = att_need(ks) ? ks : (dir ? 3 : 0);
              af[ks] = *(const bf16x8*)(apn + kse * 512); } }
        bf16x8 vs[8];
#pragma unroll
        for (int ks = 0; ks < 8; ++ks) vs[ks] = *(const LAS bf16x8*)(VSl + (cur * 32 + (l & 31)) * RS_VT + 16 * ks + 8 * (l >> 5));
        {
            bf16_t* obase = si < 2 ? dump : Ob + (size_t)tokbase(si) * 2048;
            const int t = 16 * w + (l & 15); const float qs = qd[t];
            bf16_t* orow = obase + (size_t)t * 2048 + h * 512 + sl * 32 + 4 * (l >> 4);
#pragma unroll
            for (int nt = 0; nt < 2; ++nt) { const f32x4 o = oi[nt] * qs + oa[nt]; u32x2 wv; wv.x = cvt_pk_bf16(o[0], o[1]); wv.y = cvt_pk_bf16(o[2], o[3]); *(u32x2*)(orow + 16 * nt) = wv; }
        }
#pragma unroll
        for (int i = 0; i < 16; ++i) S[i] *= cd;
        __builtin_amdgcn_sched_barrier(0);
#pragma unroll
        for (int ks = 0; ks < 8; ++ks) S = __builtin_amdgcn_mfma_f32_32x32x16_bf16(kf[ks], vs[ks], S, 0, 0, 0);
        __builtin_amdgcn_sched_barrier(0);
        { const bf16_t* kp = KT + (((size_t)h * 132 + (tbn >> 7)) * 8 + w) * 8 * 512 + l * 8;
#pragma unroll
          for (int ks = 0; ks < 8; ++ks) kf[ks] = *(const bf16x8*)(kp + ks * 512); }
#pragma unroll
        for (int g = 0; g < 4; ++g) { u32x2 wv; wv.x = cvt_pk_bf16(S[4 * g], S[4 * g + 1]); wv.y = cvt_pk_bf16(S[4 * g + 2], S[4 * g + 3]);
            *(LAS u32x2*)(STl + ((cur ^ 1) * 32 + (l & 31)) * RS_ST + 32 * w + 8 * g + 4 * (l >> 5)) = wv; }
        stage_v(vnext, cur ^ 1);
    };
    __builtin_amdgcn_s_waitcnt(0x0F70);
#pragma unroll 1
    for (int si = 0; si < NSTEP; si += 2) { step(si, qA, qB); step(si + 1, qB, qA); }
    __syncthreads();
}

__device__ __forceinline__ void ph_retout(const int vc, const Params& p) {
    const bf16_t* Gs = WSP(bf16_t, O_GS); const bf16_t* Ob = WSP(bf16_t, O_OB);
    const int tid_ = tidx(), wave = tid_ >> 6, lane = tid_ & 63;
    const int it0 = vc * 8 + wave, its = (int)gridDim.x * 8;
    auto off_of = [&](int it) -> size_t { return (size_t)(it >> 2) * 2048 + (it & 3) * 512 + 8 * lane; };
    u32x4 an = __builtin_nontemporal_load((const u32x4*)(Ob + off_of(it0))), bn = __builtin_nontemporal_load((const u32x4*)(Ob + (size_t)ML * 2048 + off_of(it0))), gn = __builtin_nontemporal_load((const u32x4*)(Gs + off_of(it0)));
    for (int it = it0; it < ML * 4; it += its) {
        const size_t o = off_of(it);
        const u32x4 a = an, bq = bn, g = gn;
        { const size_t on = off_of(it + its < ML * 4 ? it + its : it);
          an = __builtin_nontemporal_load((const u32x4*)(Ob + on)); bn = __builtin_nontemporal_load((const u32x4*)(Ob + (size_t)ML * 2048 + on)); gn = __builtin_nontemporal_load((const u32x4*)(Gs + on)); }
        const f32x4 s0 = {__uint_as_float(a.x << 16) + __uint_as_float(bq.x << 16), __uint_as_float(a.x & 0xffff0000u) + __uint_as_float(bq.x & 0xffff0000u),
                          __uint_as_float(a.y << 16) + __uint_as_float(bq.y << 16), __uint_as_float(a.y & 0xffff0000u) + __uint_as_float(bq.y & 0xffff0000u)};
        const f32x4 s1 = {__uint_as_float(a.z << 16) + __uint_as_float(bq.z << 16), __uint_as_float(a.z & 0xffff0000u) + __uint_as_float(bq.z & 0xffff0000u),
                          __uint_as_float(a.w << 16) + __uint_as_float(bq.w << 16), __uint_as_float(a.w & 0xffff0000u) + __uint_as_float(bq.w & 0xffff0000u)};
        const float ss = (s0[0] * s0[0] + s0[1] * s0[1]) + (s0[2] * s0[2] + s0[3] * s0[3]) + (s1[0] * s1[0] + s1[1] * s1[1]) + (s1[2] * s1[2] + s1[3] * s1[3]);
        const float r = rsqrtf(wave_sum(ss) * (1.f / 512.f) + EPS);
        const f32x4 g0 = {__uint_as_float(g.x << 16), __uint_as_float(g.x & 0xffff0000u), __uint_as_float(g.y << 16), __uint_as_float(g.y & 0xffff0000u)};
        const f32x4 g1 = {__uint_as_float(g.z << 16), __uint_as_float(g.z & 0xffff0000u), __uint_as_float(g.w << 16), __uint_as_float(g.w & 0xffff0000u)};
        *(u32x4*)(WSP(bf16_t, OFF_A2B) + o) = pg8::pack8(g0 * s0 * r, g1 * s1 * r);
    }
}

__device__ __forceinline__ void ph_gemm_in0(const int vc, const Params& p, LAS unsigned char* lds) {
    {   pg8::L0NormOrder S; S.init(gridDim.x, vc);
        pg8::gemm_phase<pg8::EpiZ0, pg8::L0NormOrder, false>(lds, (LAS int*)(lds + LDS_STAGE), pg8::Gemm{WSP(bf16_t, OFF_HB), WSP(bf16_t, OFF_WIN0), 0, 0, nullptr, 0, D}, S, pg8::EpiZ0{WSP(bf16_t, R2_QK0), WSP(bf16_t, R2_QK0) + (size_t)MT * 512, WSP(bf16_t, R2_U0)}); }
    __syncthreads();
    {   pg8::L0SwapOrder S; S.init(gridDim.x, vc);
        pg8::gemm_phase<pg8::EpiL0Swap, pg8::L0SwapOrder, false, 1 << 30, false, 1>(lds, (LAS int*)(lds + LDS_STAGE), pg8::Gemm{WSP(bf16_t, OFF_WIN0), WSP(bf16_t, OFF_HB), 0, 0, nullptr, 0, D}, S, pg8::EpiL0Swap{WSP(bf16_t, R2_VT0), WSP(bf16_t, R2_GVT0)}); }
}
__device__ __forceinline__ void ph_gemm_out0(const int vc, const Params& p, LAS unsigned char* lds) {
    const pg8::Gemm g{WSP(bf16_t, OFF_ABB), WSP(bf16_t, OFF_WOUT0), 0, 0, nullptr, 0, D};
    const EpiResNorm<0> E{p.ws, p.norm2_g, p.moe_router, p.x, p.ctx};
    {   pg8::PlainOrder S; S.init(ML / 256, D / 256, gridDim.x, vc);
        pg8::gemm_phase<EpiResNorm<0>, pg8::PlainOrder, false>(lds, (LAS int*)(lds + LDS_STAGE), g, S, E); }
    __syncthreads();
    {   pg8::SwapOrder S; S.init(64, 2, 0, 4, gridDim.x, vc);
        pg8::gemm_phase<EpiResNorm<0>, pg8::SwapOrder, false>(lds, (LAS int*)(lds + LDS_STAGE), g, S, E); }
}
__device__ __forceinline__ void ph_gemm_in1(const int vc, const Params& p, LAS unsigned char* lds) {
    {
        pg8::L1NormOrder S; S.init(gridDim.x, vc);
        pg8::gemm_phase<pg8::EpiL1In, pg8::L1NormOrder, false>(lds, (LAS int*)(lds + LDS_STAGE), pg8::Gemm{WSP(bf16_t, OFF_HB), WSP(bf16_t, OFF_WIN1), 0, 0, nullptr, 0, D}, S,
            pg8::EpiL1In{WSP(bf16_t, R2_Q), WSP(bf16_t, R2_KN), nullptr, WSP(bf16_t, O_GS), WSP(f32x2, OFF_ROPE)});
    }
    __syncthreads();
    {
        pg8::SwapOrder S; S.init(4, 12, 0, 64, gridDim.x, vc);
        pg8::gemm_phase<pg8::EpiL1Swap, pg8::SwapOrder, false, 1 << 30, false, 1>(lds, (LAS int*)(lds + LDS_STAGE), pg8::Gemm{WSP(bf16_t, OFF_WIN1), WSP(bf16_t, OFF_HB), 0, 0, nullptr, 0, D}, S,
            pg8::EpiL1Swap{WSP(bf16_t, R2_KT), WSP(bf16_t, R2_VT), WSP(f32x2, OFF_ROPE), WSP(f32x2, OFF_ROPE2), WSP(bf16_t, R2_KN), lds + LDS_STAGE});
    }
}
__device__ __forceinline__ void ph_att_ctxkv(const int vc, const Params& p, LAS unsigned char* lds) {
    if (gridDim.x == 256 && vc >= 24) { ph_att(vc, p, lds, 24); return; }
    if (gridDim.x != 256) { ph_att(vc, p, lds, 0); __syncthreads(); }
    pg8::SwapOrder S; S.init(4, 12, 64, 2, gridDim.x, vc);
    pg8::gemm_phase<pg8::EpiL1Swap, pg8::SwapOrder, false, 1 << 30, false, 1>(lds, (LAS int*)(lds + LDS_STAGE), pg8::Gemm{WSP(bf16_t, OFF_WIN1), WSP(bf16_t, OFF_HB), 0, 0, nullptr, 0, D}, S,
        pg8::EpiL1Swap{WSP(bf16_t, R2_KT), WSP(bf16_t, R2_VT), WSP(f32x2, OFF_ROPE), WSP(f32x2, OFF_ROPE2), WSP(bf16_t, R2_KN), lds + LDS_STAGE});
}
__device__ __forceinline__ void ph_gemm_out1(const int vc, const Params& p, LAS unsigned char* lds) {
    pg8::PlainOrder S; S.init(ML / 256, D / 256, gridDim.x, vc);
    pg8::gemm_phase<EpiResNorm<1>, pg8::PlainOrder, false>(lds, (LAS int*)(lds + LDS_STAGE), pg8::Gemm{WSP(bf16_t, OFF_A2B), WSP(bf16_t, OFF_WOUT1), 0, 0, nullptr, 0, 2048}, S, EpiResNorm<1>{p.ws, p.norm2_g + D, p.moe_router + (size_t)D * NE, nullptr, nullptr});
}
__device__ __forceinline__ void ph_gemm_gu(const int vc, const Params& p, LAS unsigned char* lds, int layer) {
    pg8::GroupedOrder S; S.init(layer ? 8 : 9, 22, 2, gridDim.x, vc);
    pg8::gemm_phase<pg8::EpiGU, pg8::GroupedOrder, true, 8>(lds, (LAS int*)(lds + LDS_STAGE), pg8::Gemm{WSP(bf16_t, OFF_HB), WSP(bf16_t, OFF_GUT) + (size_t)layer * GUT_L, 0, (size_t)2 * FF * D, WSP(int, OFF_RIDX), MEXP, D}, S, pg8::EpiGU{WSP(bf16_t, OFF_R2)});
}
__device__ __forceinline__ void ph_gemm_dn(const int vc, const Params& p, LAS unsigned char* lds, int layer) {
    const pg8::Gemm g{WSP(bf16_t, OFF_R2), WSP(bf16_t, OFF_DNT) + (size_t)layer * DNT_L, (size_t)MEXP * FF, (size_t)D * FF, nullptr, 0, FF};
    const pg8::EpiDown E{WSP(bf16_t, OFF_YEB), WSP(float, OFF_GATE)};
    if (layer == 0) { pg8::DnSplitOrder S; S.init(gridDim.x, vc); pg8::gemm_phase<pg8::EpiDown, pg8::DnSplitOrder, false, 8, true, 3>(lds, (LAS int*)(lds + LDS_STAGE), g, S, E); }
    else { pg8::GroupedOrder S; S.init(8, 4, 4, gridDim.x, vc); pg8::gemm_phase<pg8::EpiDown, pg8::GroupedOrder, false, 1 << 30, false, 3>(lds, (LAS int*)(lds + LDS_STAGE), g, S, E); }
}

constexpr int NPHASE = 18;
template <int PH>
__device__ __forceinline__ void run_phase(const int vc, const Params& p, LAS unsigned char* lds) {
    if constexpr (PH == 0) ph_prologue(vc, p, lds);
    if constexpr (PH == 1) ph_normmod<false, true>(vc, p, lds, 0, MT, p.norm1_g, 0, D);
    if constexpr (PH == 2) ph_gemm_in0(vc, p, lds);
    if constexpr (PH == 3) { ph_sgu2(vc, p, lds); ph_na2(vc, p, lds); }
    if constexpr (PH == 4) ph_gemm_out0(vc, p, lds);
    if constexpr (PH == 5) ph_topk(vc, p, lds, true);
    if constexpr (PH == 6) ph_gemm_gu(vc, p, lds, 0);
    if constexpr (PH == 7) ph_gemm_dn(vc, p, lds, 0);
    if constexpr (PH == 8) ph_combine<false>(vc, p, 0, MT);
    if constexpr (PH == 9) ph_gemm_in1(vc, p, lds);
    if constexpr (PH == 10) ph_att_ctxkv(vc, p, lds);
    if constexpr (PH == 11) ph_rscan(vc, p, lds);
    if constexpr (PH == 12) ph_retout(vc, p);
    if constexpr (PH == 13) ph_gemm_out1(vc, p, lds);
    if constexpr (PH == 14) ph_topk(vc, p, lds, false);
    if constexpr (PH == 15) ph_gemm_gu(vc, p, lds, 1);
    if constexpr (PH == 16) ph_gemm_dn(vc, p, lds, 1);
    if constexpr (PH == 17) ph_combine<true>(vc, p, 1, ML);
}

template <int PH> __device__ __forceinline__ void run_all(const int vc, const Params& p, LAS unsigned char* lds, const XcdBarrier& bar) {
    run_phase<PH>(vc, p, lds);
    if constexpr (PH + 1 < NPHASE) { xcd_barrier(bar); run_all<PH + 1>(vc, p, lds, bar); }
}

__global__ __launch_bounds__(NTHR, 2) void mega(Params p) {
    extern __shared__ __attribute__((aligned(16))) unsigned char smem[];
    LAS unsigned char* lds = (LAS unsigned char*)smem;
    volatile LAS unsigned* st = (volatile LAS unsigned*)(lds + LDS_BYTES - 16);
    if (threadIdx.x == 0) { st[0] = 0u; st[1] = 0u; st[2] = 0u; st[3] = 0u; }
    __syncthreads();
    XcdBarrier bar; bar.bar = WSP(unsigned, OFF_BAR); bar.x = xb_xcc_id(); bar.st = st;
    if (threadIdx.x == 0) st[2] = xb_add(&bar.bar[XB_XCNT(bar.x)], 1u);
    run_phase<0>((int)blockIdx.x, p, lds);
    xcd_barrier(bar);
    if (threadIdx.x == 0) {
        bool uni = gridDim.x == 256;
#pragma unroll
        for (unsigned j = 0; j < 16; ++j) { const unsigned cnt = xb_ld(&bar.bar[XB_XCNT(j)]); uni = uni && (cnt == (j < 8 ? 32u : 0u)); }
        st[3] = uni ? st[2] * 8u + bar.x : blockIdx.x;
    }
    __syncthreads();
    const int vc = (int)st[3];
    run_all<1>(vc, p, lds, bar);
}
}

extern "C" void kernel_launch(void* const* d_in, const int* in_sizes, int n_in, void* d_out, int out_size, void* d_ws, size_t ws_size, hipStream_t stream) {
    Params p{};
    p.x = (const float*)d_in[0]; p.c = (const float*)d_in[1]; p.ctx = (const float*)d_in[2]; p.c_ctx = (const float*)d_in[3];
    p.ada_w = (const float*)d_in[4]; p.ada_b = (const float*)d_in[5]; p.norm1_g = (const float*)d_in[6]; p.norm2_g = (const float*)d_in[7];
    p.ab_w_in = (const float*)d_in[8]; p.ab_w_out = (const float*)d_in[9]; p.na_rpb = (const float*)d_in[10]; p.sgu_norm_g = (const float*)d_in[11];
    p.sgu_w = (const float*)d_in[12]; p.sgu_b = (const float*)d_in[13]; p.ret_w_in = (const float*)d_in[14]; p.ret_w_out = (const float*)d_in[15];
    p.ret_decay = (const float*)d_in[16]; p.moe_router = (const float*)d_in[17]; p.moe_w_gate = (const float*)d_in[18]; p.moe_w_up = (const float*)d_in[19];
    p.moe_w_down = (const float*)d_in[20]; p.final_g = (const float*)d_in[21];
    p.out = (float*)d_out;
    p.ws = (char*)d_ws;

    if (ws_size < WS_END) { fprintf(stderr, "kernel_launch: workspace of %zu bytes is smaller than the %zu bytes this kernel needs; nothing launched\n", ws_size, (size_t)WS_END); return; }
    static bool attr_done = false;
    if (!attr_done) { (void)hipFuncSetAttribute((const void*)mega, hipFuncAttributeMaxDynamicSharedMemorySize, LDS_BYTES); attr_done = true; }
    (void)hipMemsetAsync(p.ws + OFF_BAR, 0, ZERO_BYTES, stream);
    hipLaunchKernelGGL(mega, dim3(NWG), dim3(NTHR), LDS_BYTES, stream, p);
}
```

```cpp
#include <hip/hip_runtime.h>
#include <stdint.h>
#include <cstdio>

#define LAS __attribute__((address_space(3)))
typedef unsigned short bf16_t;
typedef short bf16x8 __attribute__((ext_vector_type(8)));
typedef float f32x4 __attribute__((ext_vector_type(4)));
typedef float f32x2 __attribute__((ext_vector_type(2)));
typedef unsigned u32x4 __attribute__((ext_vector_type(4)));
typedef unsigned u32x2 __attribute__((ext_vector_type(2)));

namespace {
constexpr int D = 1024, NB = 2, SEQ = 8192, CTX = 256;
constexpr int ML = NB * SEQ;
constexpr int MC = NB * CTX;
constexpr int MT = ML + MC;
constexpr int ABIN = 2560;
constexpr int RIN = 6144;
constexpr int NE = 16, FF = 2816, CAPL = 1024, CAPC = 32;
constexpr int MEXP = 2304;
constexpr float EPS = 1e-6f;
constexpr int MODW = 6 * D;
constexpr int NWG = 256, NTHR = 512;
constexpr int LDS_STAGE = 131072, LDS_IDX = 16384, LDS_BYTES = LDS_STAGE + LDS_IDX + 8192;

__device__ __forceinline__ float bf2f(bf16_t v) { return __uint_as_float((unsigned)v << 16); }
__device__ __forceinline__ bf16_t f2bf(float v) { unsigned u = __float_as_uint(v); u += 0x7fffu + ((u >> 16) & 1u); return (bf16_t)(u >> 16); }
__device__ __forceinline__ float rbf(float v) { return bf2f(f2bf(v)); }
typedef __bf16 bf16v2_t __attribute__((ext_vector_type(2)));
__device__ __forceinline__ unsigned cvt_pk_bf16(float lo, float hi) { const f32x2 v = {lo, hi}; const bf16v2_t r = __builtin_convertvector(v, bf16v2_t); return __builtin_bit_cast(unsigned, r); }

__device__ __forceinline__ int tidx() { int t = threadIdx.x; asm volatile("" : "+v"(t)); return t; }

#define WAVE_ALLREDUCE(OP) \
    v = OP(v, __uint_as_float((unsigned)__builtin_amdgcn_update_dpp(0, (int)__float_as_uint(v), 0xB1, 0xf, 0xf, true)));    \
    v = OP(v, __uint_as_float((unsigned)__builtin_amdgcn_update_dpp(0, (int)__float_as_uint(v), 0x4E, 0xf, 0xf, true)));    \
    v = OP(v, __uint_as_float((unsigned)__builtin_amdgcn_update_dpp(0, (int)__float_as_uint(v), 0x141, 0xf, 0xf, true)));   \
    v = OP(v, __uint_as_float((unsigned)__builtin_amdgcn_update_dpp(0, (int)__float_as_uint(v), 0x140, 0xf, 0xf, true)));   \
    { const auto r = __builtin_amdgcn_permlane16_swap(__float_as_uint(v), __float_as_uint(v), false, false); v = OP(__uint_as_float(r[0]), __uint_as_float(r[1])); } \
    { const auto r = __builtin_amdgcn_permlane32_swap(__float_as_uint(v), __float_as_uint(v), false, false); v = OP(__uint_as_float(r[0]), __uint_as_float(r[1])); }
__device__ __forceinline__ float op_add(float a, float b) { return a + b; }
__device__ __forceinline__ float wave_sum(float v) { WAVE_ALLREDUCE(op_add) return v; }
__device__ __forceinline__ float wave_max(float v) { WAVE_ALLREDUCE(fmaxf) return v; }
__device__ __forceinline__ float half_max(float v) { const auto r = __builtin_amdgcn_permlane32_swap(__float_as_uint(v), __float_as_uint(v), false, false); return fmaxf(__uint_as_float(r[0]), __uint_as_float(r[1])); }
__device__ __forceinline__ float half_sum(float v) { const auto r = __builtin_amdgcn_permlane32_swap(__float_as_uint(v), __float_as_uint(v), false, false); return __uint_as_float(r[0]) + __uint_as_float(r[1]); }
__device__ __forceinline__ float block_sum256(float v, float* sh) {
    v = wave_sum(v);
    __syncthreads();
    if ((threadIdx.x & 63) == 0) sh[threadIdx.x >> 6] = v;
    __syncthreads();
    return sh[0] + sh[1] + sh[2] + sh[3];
}
__device__ __forceinline__ float silu_f(float v) { return v / (1.f + expf(-v)); }
__device__ __forceinline__ float gelu_tanh(float x) { return 0.5f * x * (1.f + tanhf(0.7978845608028654f * (x + 0.044715f * x * x * x))); }
__device__ __forceinline__ float silu_fast(float v) { return v * __builtin_amdgcn_rcpf(1.f + __builtin_amdgcn_exp2f(-1.4426950408889634f * v)); }
__device__ __forceinline__ float gelu_fast(float x) { const float u = 0.7978845608028654f * (x + 0.044715f * x * x * x); return x * __builtin_amdgcn_rcpf(1.f + __builtin_amdgcn_exp2f(-2.8853900817779268f * u)); }

namespace pg8 {
constexpr int BM = 256, BK = 64, HALF = 128, HTB = HALF * BK * 2, STAGE_BYTES = 8 * HTB, NXCD = 8, WGM = 8;
__host__ __device__ __forceinline__ int lds_byte(int r, int c) { return (r >> 3) * 1024 + (r & 7) * 128 + ((((c >> 3) ^ r) & 7) << 4) + (c & 7) * 2; }
__host__ __device__ __forceinline__ void stage_rc(int b, int& R, int& C) { const int blk = b / 1024, pos = (b % 1024) / 16; R = blk * 8 + (pos >> 3); C = (((pos ^ R) & 7)) * 8; }
__host__ __device__ __forceinline__ int perm32(int rho) { const int n = rho >> 4, i = rho & 15; return 8 * (i >> 2) + 4 * n + (i & 3); }

struct Unit { int z, pm, pn, kq; };
struct Gemm { const bf16_t* A; const bf16_t* Bt; size_t aStrideZ, bStrideZ; const int* ridx; long long ridxStrideZ; long long K; };

struct PlainOrder {
    int nM, nN, nwg, G, c;
    __device__ void init(int nM_, int nN_, int G_, int c_) { nM = nM_; nN = nN_; nwg = nM * nN; G = G_; c = c_; }
    __device__ bool map(long L, Unit& u) const {
        if (L >= nwg) return false;
        int wgid = (int)L; { const int q = nwg / NXCD, r = nwg % NXCD, xcd = wgid % NXCD, off = wgid / NXCD; wgid = (xcd < r ? xcd * (q + 1) : r * (q + 1) + (xcd - r) * q) + off; }
        const int nig = WGM * nN, gid = wgid / nig, fm = gid * WGM, gsz = (nM - fm) < WGM ? (nM - fm) : WGM;
        u.kq = -1; u.z = 0; u.pm = fm + ((wgid % nig) % gsz); u.pn = (wgid % nig) / gsz; return true;
    }
    __device__ bool next(int i, Unit& u) const { return map((long)i * G + c, u); }
};
struct InProj1Order {
    PlainOrder p; int G, c;
    __device__ void init(int G_, int c_) { p.init(64, 24, G_, c_); G = G_; c = c_; }
    __device__ bool next(int i, Unit& u) const {
        const long L = (long)i * G + c;
        if (L < 1536) return p.map(L, u);
        const int r = (int)(L - 1536); if (r >= 24) return false;
        u.kq = -1; u.z = 0; u.pm = 64 + r / 12; u.pn = 4 + r % 12; return true;
    }
};
struct L0NormOrder {
    PlainOrder p;
    __device__ void init(int G_, int c_) { p.init(66, 6, G_, c_); }
    __device__ bool next(int i, Unit& u) const { if (!p.next(i, u)) return false; if (u.pn >= 4) u.pn += 2; return true; }
};
struct L0SwapOrder {
    int G, c;
    __device__ void init(int G_, int c_) { G = G_; c = G_ - 1 - c_; }
    __device__ bool next(int i, Unit& u) const { const int L = i * G + c; if (L >= 4 * 66) return false; const int wi = L / 66; u.kq = -1; u.z = 0; u.pm = wi < 2 ? 4 + wi : 6 + wi; u.pn = L % 66; return true; }
};
struct L1NormOrder {
    PlainOrder p;
    __device__ void init(int G_, int c_) { p.init(64, 12, G_, c_); }
    __device__ bool next(int i, Unit& u) const { if (!p.next(i, u)) return false; if (u.pn >= 4) u.pn += 12; return true; }
};
struct SwapOrder {
    int wt0, nTok, tok0, total, G, c;
    __device__ void init(int wt0_, int nWT_, int tok0_, int nTok_, int G_, int c_) { wt0 = wt0_; nTok = nTok_; tok0 = tok0_; total = nWT_ * nTok_; G = G_; c = c_; }
    __device__ bool next(int i, Unit& u) const { const int L = i * G + c; if (L >= total) return false; u.kq = -1; u.z = 0; u.pm = wt0 + L / nTok; u.pn = tok0 + L % nTok; return true; }
};
struct GroupedOrder {
    int nM, nN, GP, G, c;
    __device__ void init(int nM_, int nN_, int GP_, int G_, int c_) { nM = nM_; nN = nN_; GP = GP_; G = G_; c = c_; }
    __device__ bool next(int i, Unit& u) const {
        const int x = c & 7, j = (c >> 3) + i * (G >> 3), per = nM * nN;
        if (j >= 2 * per) return false;
        const int el = j / per, rem = j % per, grp = rem / (nM * GP), w = rem % (nM * GP);
        u.kq = -1; u.z = 2 * x + el; u.pm = w % nM; u.pn = grp * GP + w / nM; return true;
    }
};

struct CtxKvOrder {
    int c;
    __device__ void init(int c_) { c = c_; }
    __device__ bool next(int i, Unit& u) const { if (i > 0 || c >= 48) return false; const int t = c >> 1; u.kq = c & 1; u.z = 0; u.pm = 4 + (t >> 1); u.pn = 64 + (t & 1); return true; }
};
struct DnSplitOrder {
    int G, c;
    __device__ void init(int G_, int c_) { G = G_; c = c_; }
    __device__ bool next(int i, Unit& u) const {
        const int x = c & 7, j = (c >> 3) + i * (G >> 3);
        if (j >= 96) return false;
        const int g = j / 12, k = j - 12 * g;
        u.z = 2 * x + (g >> 2); u.pn = g & 3;
        if (k < 8) { u.kq = -1; u.pm = k; } else { u.kq = k - 8; u.pm = 8; }
        return true;
    }
};
__device__ __forceinline__ u32x4 pack8(const f32x4 a, const f32x4 b) { u32x4 w; w.x = cvt_pk_bf16(a[0], a[1]); w.y = cvt_pk_bf16(a[2], a[3]); w.z = cvt_pk_bf16(b[0], b[1]); w.w = cvt_pk_bf16(b[2], b[3]); return w; }

struct EpiZ0 {
    static constexpr bool PERM = true, FUSED = false;
    bf16_t* QN; bf16_t* KN; bf16_t* U;
    __device__ __forceinline__ void operator()(const f32x4 (&acc)[2][2][4][2], const Unit& u, int wr, int wc, int fr, int fq) const {
        const int row0 = u.pm * BM + wr * 64 + fr;
        if (u.pn >= 6) {
            const int col0 = (u.pn - 6) * BM + wc * 32 + 8 * fq;
#pragma unroll
            for (int ai = 0; ai < 2; ++ai)
#pragma unroll
                for (int m = 0; m < 4; ++m) { bf16_t* rowp = U + (size_t)(row0 + ai * HALF + m * 16) * 512 + col0;
#pragma unroll
                    for (int bj = 0; bj < 2; ++bj) { f32x4 v0 = acc[ai][bj][m][0], v1 = acc[ai][bj][m][1];
#pragma unroll
                        for (int j = 0; j < 4; ++j) { v0[j] = gelu_fast(v0[j]); v1[j] = gelu_fast(v1[j]); }
                        *(u32x4*)(rowp + bj * HALF) = pack8(v0, v1); } }
        } else {
            bf16_t* O = u.pn < 2 ? QN : KN; const int cb = (u.pn & 1) * BM + wc * 32 + 8 * fq;
#pragma unroll
            for (int ai = 0; ai < 2; ++ai)
#pragma unroll
                for (int m = 0; m < 4; ++m) { const int tok = row0 + ai * HALF + m * 16;
#pragma unroll
                    for (int bj = 0; bj < 2; ++bj) { const int c = cb + bj * HALF, head = c >> 6, d0 = c & 63;
                        *(u32x4*)(O + ((((size_t)(tok >> 5) * 8 + head) * 4 + (d0 >> 4)) * 64 + 32 * ((d0 >> 3) & 1) + (tok & 31)) * 8) = pack8(acc[ai][bj][m][0], acc[ai][bj][m][1]); } }
        }
    }
};
struct EpiL0Swap {
    static constexpr bool PERM = true, FUSED = false;
    bf16_t* VN; bf16_t* GVT;
    __device__ __forceinline__ void operator()(const f32x4 (&acc)[2][2][4][2], const Unit& u, int wr, int wc, int fr, int fq) const {
        const int col0 = u.pn * BM + wc * 32 + 8 * fq;
        if (u.pm >= 8) {
            const int rb = (u.pm - 8) * BM + wr * 64 + fr;
#pragma unroll
            for (int ai = 0; ai < 2; ++ai)
#pragma unroll
                for (int m = 0; m < 4; ++m)
#pragma unroll
                    for (int bj = 0; bj < 2; ++bj) { f32x4 v0 = acc[ai][bj][m][0], v1 = acc[ai][bj][m][1];
#pragma unroll
                        for (int j = 0; j < 4; ++j) { v0[j] = gelu_fast(v0[j]); v1[j] = gelu_fast(v1[j]); }
                        *(u32x4*)(GVT + (size_t)(rb + ai * HALF + m * 16) * MT + col0 + bj * HALF) = pack8(v0, v1); }
        } else {
#pragma unroll
            for (int ai = 0; ai < 2; ++ai)
#pragma unroll
                for (int m = 0; m < 4; ++m) { const int c = (u.pm - 4) * BM + ai * HALF + wr * 64 + m * 16 + fr, head = c >> 6, d = c & 63;
#pragma unroll
                    for (int bj = 0; bj < 2; ++bj) { const int T0 = col0 + bj * HALF;
                        const u32x4 w8 = pack8(acc[ai][bj][m][0], acc[ai][bj][m][1]);
                        bf16_t* base = VN + (((((size_t)(T0 >> 5) * 8 + head) * 2 + (d >> 5)) * 2 + ((T0 >> 4) & 1)) * 64 + (d & 31)) * 8 + 4 * ((T0 >> 3) & 1);
                        *(u32x2*)(base) = (u32x2){w8.x, w8.y};
                        *(u32x2*)(base + 32 * 8) = (u32x2){w8.z, w8.w}; } }
        }
    }
};
template <bool SRC_BF16> struct EpiRes {
    static constexpr bool PERM = true, FUSED = false;
    bf16_t* X; const float* srcL; const float* srcC; const float* gate;
    __device__ __forceinline__ void operator()(const f32x4 (&acc)[2][2][4][2], const Unit& u, int wr, int wc, int fr, int fq) const {
        const int row0 = u.pm * BM + wr * 64 + fr, col0 = u.pn * BM + wc * 32 + 8 * fq;
        const float* gp = gate + (u.pm < 64 ? u.pm / 32 : 2) * MODW + col0;
        const float* sp = u.pm < 64 ? srcL + (size_t)row0 * D + col0 : srcC + (size_t)(row0 - ML) * D + col0;
        f32x4 gv[2][2];
#pragma unroll
        for (int bj = 0; bj < 2; ++bj)
#pragma unroll
            for (int n = 0; n < 2; ++n) gv[bj][n] = *(const f32x4*)(gp + bj * HALF + 4 * n);
#pragma unroll
        for (int ai = 0; ai < 2; ++ai)
#pragma unroll
            for (int m = 0; m < 4; ++m) { const size_t ro = (size_t)(ai * HALF + m * 16) * D; bf16_t* rowp = X + (size_t)row0 * D + col0 + ro;
#pragma unroll
                for (int bj = 0; bj < 2; ++bj) { f32x4 s0, s1;
                    if (SRC_BF16) { const u32x4 xb = *(const u32x4*)(rowp + bj * HALF);
                        s0 = (f32x4){__uint_as_float(xb.x << 16), __uint_as_float(xb.x & 0xffff0000u), __uint_as_float(xb.y << 16), __uint_as_float(xb.y & 0xffff0000u)};
                        s1 = (f32x4){__uint_as_float(xb.z << 16), __uint_as_float(xb.z & 0xffff0000u), __uint_as_float(xb.w << 16), __uint_as_float(xb.w & 0xffff0000u)}; }
                    else { s0 = __builtin_nontemporal_load((const f32x4*)(sp + ro + bj * HALF)); s1 = __builtin_nontemporal_load((const f32x4*)(sp + ro + bj * HALF + 4)); }
                    *(u32x4*)(rowp + bj * HALF) = pack8(s0 + gv[bj][0] * acc[ai][bj][m][0], s1 + gv[bj][1] * acc[ai][bj][m][1]); } }
    }
};
struct EpiL1In {
    static constexpr bool PERM = true, FUSED = false;
    bf16_t* Q; bf16_t* Kb; bf16_t* V; bf16_t* Gs; const f32x2* rope;
    __device__ __forceinline__ void operator()(const f32x4 (&acc)[2][2][4][2], const Unit& u, int wr, int wc, int fr, int fq) const {
        const int row0 = u.pm * BM + wr * 64 + fr, cl = wc * 32 + 8 * fq;
        if (u.pn < 8) {
            const bool isq = u.pn < 4; const int head = isq ? u.pn : u.pn - 4; bf16_t* O = isq ? Q : Kb; const float sc = isq ? 1.f : 0.0625f;
            const bool lat = u.pm < 64;
#pragma unroll
            for (int ai = 0; ai < 2; ++ai)
#pragma unroll
                for (int m = 0; m < 4; ++m) {
                    const int row = row0 + ai * HALF + m * 16; const int t = row & (SEQ - 1);
                    const int pos = wc < 2 ? (t >> 6) : (t & 63);
                    const f32x4* tp = (const f32x4*)(rope + pos * 64 + (wc & 1) * 32 + 8 * fq);
                    f32x4 o1[2], o2[2];
#pragma unroll
                    for (int n = 0; n < 2; ++n) {
                        const f32x4 x1 = acc[ai][0][m][n], x2 = acc[ai][1][m][n];
                        if (lat) { const f32x4 cs0 = tp[2 * n], cs1 = tp[2 * n + 1];
                            o1[n][0] = (x1[0] * cs0[0] - x2[0] * cs0[1]) * sc; o2[n][0] = (x1[0] * cs0[1] + x2[0] * cs0[0]) * sc;
                            o1[n][1] = (x1[1] * cs0[2] - x2[1] * cs0[3]) * sc; o2[n][1] = (x1[1] * cs0[3] + x2[1] * cs0[2]) * sc;
                            o1[n][2] = (x1[2] * cs1[0] - x2[2] * cs1[1]) * sc; o2[n][2] = (x1[2] * cs1[1] + x2[2] * cs1[0]) * sc;
                            o1[n][3] = (x1[3] * cs1[2] - x2[3] * cs1[3]) * sc; o2[n][3] = (x1[3] * cs1[3] + x2[3] * cs1[2]) * sc;
                        } else { o1[n] = x1 * sc; o2[n] = x2 * sc; }
                    }
                    bf16_t* fp = O + ((((size_t)(row >> 13) * 4 + head) * 512 + (t >> 4)) * 8 + wc) * 512 + ((t & 15) + 16 * fq) * 8;
                    *(u32x4*)(fp) = pack8(o1[0], o1[1]);
                    *(u32x4*)(fp + 4 * 512) = pack8(o2[0], o2[1]);
                }
        } else {
            const bool isv = u.pn < 16; bf16_t* O = isv ? V : Gs; const int ct = (isv ? u.pn - 8 : u.pn - 16) * BM + cl;
#pragma unroll
            for (int ai = 0; ai < 2; ++ai)
#pragma unroll
                for (int m = 0; m < 4; ++m) { bf16_t* rowp = O + (size_t)(row0 + ai * HALF + m * 16) * 2048 + ct;
#pragma unroll
                    for (int bj = 0; bj < 2; ++bj) { f32x4 v0 = acc[ai][bj][m][0], v1 = acc[ai][bj][m][1];
                        if (isv) *(u32x4*)(rowp + bj * HALF) = pack8(v0, v1); else __builtin_nontemporal_store(pack8(v0, v1), (u32x4*)(rowp + bj * HALF)); } }
        }
    }
};
struct EpiL1Swap {
    static constexpr bool PERM = true, FUSED = false;
    bf16_t* KT; bf16_t* VT; const f32x2* rope; const f32x2* rope2;
    bf16_t* KF; LAS unsigned char* scr;
    __device__ __forceinline__ void operator()(const f32x4 (&acc)[2][2][4][2], const Unit& u, int wr, int wc, int fr, int fq) const {
        const int col0 = u.pn * BM + wc * 32 + 8 * fq;
        if (u.pm < 8) {
            const int head = u.pm - 4; const bool lat = u.pn < 64;
#pragma unroll
            for (int m = 0; m < 4; ++m) {
                const int f = 16 * m + fr, r1 = head * 256 + wr * 64 + f;
#pragma unroll
                for (int bj = 0; bj < 2; ++bj) {
                    f32x4 o1[2], o2[2];
#pragma unroll
                    for (int n = 0; n < 2; ++n) {
                        const f32x4 x1 = acc[0][bj][m][n], x2 = acc[1][bj][m][n];
                        if (lat) {
                            f32x4 cc, ss;
                            if (wr == 0) { const int pos = ((u.pn * BM + bj * HALF + wc * 32) & (SEQ - 1)) >> 6; const f32x2 cs = rope[pos * 64 + f];
                                cc = (f32x4){cs.x, cs.x, cs.x, cs.x}; ss = (f32x4){cs.y, cs.y, cs.y, cs.y}; }
                            else { const f32x4* tp = (const f32x4*)(rope2 + f * 128 + (wc & 1) * 32 + 8 * fq + 4 * n); const f32x4 a = tp[0], b = tp[1];
                                cc = (f32x4){a[0], a[2], b[0], b[2]}; ss = (f32x4){a[1], a[3], b[1], b[3]}; }
                            o1[n] = (x1 * cc - x2 * ss) * 0.0625f; o2[n] = (x1 * ss + x2 * cc) * 0.0625f;
                        } else { o1[n] = x1 * 0.0625f; o2[n] = x2 * 0.0625f; }
                    }
                    const int dk = wr * 64 + f; bf16_t* fp = KT + ((((size_t)head * 132 + 2 * u.pn + bj) * 8 + (dk >> 5)) * 8 + 2 * wc + (fq >> 1)) * 512 + (32 * (fq & 1) + (dk & 31)) * 8;
                    if (u.kq != 1) *(u32x4*)(fp) = pack8(o1[0], o1[1]);
                    if (u.kq != 0) *(u32x4*)(fp + (size_t)4 * 8 * 512) = pack8(o2[0], o2[1]);
                    if (lat) {
                        LAS bf16_t* tl = (LAS bf16_t*)(scr + (wr * 4 + wc) * 2048);
                        *(LAS u32x4*)(tl + fr * 32 + 8 * fq) = pack8(o1[0], o1[1]);
                        *(LAS u32x4*)(tl + 512 + fr * 32 + 8 * fq) = pack8(o2[0], o2[1]);
                        asm volatile("s_waitcnt lgkmcnt(0)" ::: "memory");
                        const int L = fr + 16 * fq, tt = L & 31, hf = L >> 5, T = u.pn * BM + bj * HALF + wc * 32 + tt, t = T & (SEQ - 1);
#pragma unroll
                        for (int part = 0; part < 2; ++part) { const LAS bf16_t* sp = tl + part * 512 + (hf * 8) * 32 + tt; u32x4 w8;
                            w8.x = (unsigned)sp[0] | ((unsigned)sp[32] << 16); w8.y = (unsigned)sp[64] | ((unsigned)sp[96] << 16); w8.z = (unsigned)sp[128] | ((unsigned)sp[160] << 16); w8.w = (unsigned)sp[192] | ((unsigned)sp[224] << 16);
                            const int dk0 = wr * 64 + 16 * m + 8 * hf + 128 * part;
                            *(u32x4*)(KF + ((((size_t)(T >> 13) * 4 + head) * 512 + (t >> 4)) * 8 + (dk0 >> 5)) * 512 + ((t & 15) + 16 * ((dk0 >> 3) & 3)) * 8) = w8; }
                        asm volatile("s_waitcnt lgkmcnt(0)" ::: "memory");
                    }
                }
            }
        } else {
            const int rb = (u.pm - 8) * BM + wr * 64 + fr;
#pragma unroll
            for (int ai = 0; ai < 2; ++ai) { if (u.kq >= 0 && u.kq != ai) continue;
#pragma unroll
                for (int m = 0; m < 4; ++m)
#pragma unroll
                    for (int bj = 0; bj < 2; ++bj) *(u32x4*)(VT + (size_t)(rb + ai * HALF + m * 16) * MT + col0 + bj * HALF) = pack8(acc[ai][bj][m][0], acc[ai][bj][m][1]); }
        }
    }
};
struct EpiGU {
    static constexpr bool PERM = true, FUSED = false;
    bf16_t* HID;
    __device__ __forceinline__ void operator()(const f32x4 (&acc)[2][2][4][2], const Unit& u, int wr, int wc, int fr, int fq) const {
        const int row0 = u.pm * BM + wr * 64 + fr, col0 = u.pn * HALF + wc * 32 + 8 * fq;
        bf16_t* base = HID + (size_t)u.z * MEXP * FF;
#pragma unroll
        for (int ai = 0; ai < 2; ++ai)
#pragma unroll
            for (int m = 0; m < 4; ++m) { f32x4 h[2];
#pragma unroll
                for (int n = 0; n < 2; ++n)
#pragma unroll
                    for (int j = 0; j < 4; ++j) h[n][j] = silu_fast(acc[ai][0][m][n][j]) * acc[ai][1][m][n][j];
                const int row = row0 + ai * HALF + m * 16;
                *(u32x4*)(base + ((size_t)(row >> 7) * (FF / 64) + (col0 >> 6)) * 8192 + (row & 127) * 64 + (col0 & 63)) = pack8(h[0], h[1]); }
    }
};
struct EpiDown {
    static constexpr bool PERM = true, FUSED = false;
    bf16_t* YE; const float* gateval;
    __device__ __forceinline__ void operator()(const f32x4 (&acc)[2][2][4][2], const Unit& u, int wr, int wc, int fr, int fq) const {
        const int row0 = u.pm * BM + wr * 64 + fr, col0 = u.pn * BM + wc * 32 + 8 * fq;
        bf16_t* base = YE + (size_t)u.z * MEXP * D; const float* gvp = gateval + u.z * MEXP;
        if (u.kq >= 0) {
            if (wr == 0) {
#pragma unroll
                for (int m = 0; m < 4; ++m) { const int row = row0 + m * 16; const float gsc = gvp[row];
#pragma unroll
                    for (int bj = 0; bj < 2; ++bj) *(u32x4*)(base + (size_t)(row + 64 * u.kq) * D + col0 + bj * HALF) = pack8(acc[0][bj][m][0] * gsc, acc[0][bj][m][1] * gsc); }
            }
            return;
        }
#pragma unroll
        for (int ai = 0; ai < 2; ++ai)
#pragma unroll
            for (int m = 0; m < 4; ++m) { const int row = row0 + ai * HALF + m * 16; const float gsc = gvp[row];
#pragma unroll
                for (int bj = 0; bj < 2; ++bj) *(u32x4*)(base + (size_t)row * D + col0 + bj * HALF) = pack8(acc[ai][bj][m][0] * gsc, acc[ai][bj][m][1] * gsc); }
    }
};

template <class Epi, class Sched, bool GATHER, int SHORT_PM = 1 << 30, bool SPLITK = false, int TILED = 2, bool HALFM = false>
__device__ __forceinline__ void gemm_phase(LAS unsigned char* lds, LAS int* idxl, const Gemm g, const Sched& S, const Epi& E) {
    const int tid = tidx(), wid = __builtin_amdgcn_readfirstlane(tid >> 6), lane = tid & 63, wr = wid >> 2, wc = wid & 3, fr = lane & 15, fq = lane >> 4;
    const int K = (int)g.K, ntf = K / BK;
    int sR[2], sC[2]; unsigned voffB[2], voffA[2][2], voffN[2][2];
#pragma unroll
    for (int i = 0; i < 2; ++i) { stage_rc(tid * 16 + i * 8192, sR[i], sC[i]); const int Rb = Epi::PERM ? ((sR[i] & ~31) + perm32(sR[i] & 31)) : sR[i];
        voffB[i] = (TILED & 2) ? (unsigned)(Rb * BK + sC[i]) * 2u : (unsigned)(Rb * K + sC[i]) * 2u; }
    constexpr size_t kstepA = (TILED & 1) ? (size_t)HALF * BK * 2 : (size_t)(BK * 2), kstepB = (TILED & 2) ? (size_t)HALF * BK * 2 : (size_t)(BK * 2);
    const size_t hstep = (size_t)HALF * K * 2;
    const size_t tstep = 2 * hstep;
    const unsigned ldsw = (unsigned)wid * 1024u;
    const int aoff = lds_byte(wr * 64 + fr, fq * 8), boff = lds_byte(wc * 32 + fr, fq * 8);
#define PG8_SA(b, h) (((b) * 2 + (h)) * HTB)
#define PG8_SB(b, h) ((4 + (b) * 2 + (h)) * HTB)
#define PG8_STAGE(bufoff, gbase, voff) do { _Pragma("unroll") for (int _i = 0; _i < 2; ++_i) \
        __builtin_amdgcn_global_load_lds((const unsigned*)((const char*)(gbase) + (voff)[_i]), (LAS unsigned*)(lds + (bufoff) + ldsw + _i * 8192), 16, 0, 0); } while (0)
#define PG8_LDA(dst, b, h) do { _Pragma("unroll") for (int m = 0; m < 4; ++m) _Pragma("unroll") for (int k = 0; k < 2; ++k) dst[m][k] = *(const LAS bf16x8*)(lds + PG8_SA(b, h) + ((aoff ^ (k * 64)) + m * 2048)); } while (0)
#define PG8_LDB(dst, b, h) do { _Pragma("unroll") for (int n = 0; n < 2; ++n) _Pragma("unroll") for (int k = 0; k < 2; ++k) dst[n][k] = *(const LAS bf16x8*)(lds + PG8_SB(b, h) + ((boff ^ (k * 64)) + n * 2048)); } while (0)
#define PG8_MMA(ai, bj, At, Bt) do { __builtin_amdgcn_s_setprio(1); _Pragma("unroll") for (int m = 0; m < 4; ++m) _Pragma("unroll") for (int n = 0; n < 2; ++n) _Pragma("unroll") for (int k = 0; k < 2; ++k) \
        acc[ai][bj][m][n] = __builtin_amdgcn_mfma_f32_16x16x32_bf16(Bt[n][k], At[m][k], acc[ai][bj][m][n], 0, 0, 0); __builtin_amdgcn_s_setprio(0); } while (0)
#define PG8_WAIT_V(n) asm volatile("s_waitcnt vmcnt(" #n ")" ::: "memory")
#define PG8_WAIT_L(n) asm volatile("s_waitcnt lgkmcnt(" #n ")" ::: "memory")
#define PG8_BAR __builtin_amdgcn_s_barrier()
#define PG8_SCHED __builtin_amdgcn_sched_barrier(0)
    Unit cur, nxt; int ui = 0;
    if (!S.next(0, cur)) return;
    if constexpr (GATHER) {
        for (int k = tid >> 8;; k += 2) { Unit u; if (!S.next(k, u)) break; idxl[k * 256 + (tid & 255)] = g.ridx[(size_t)u.z * g.ridxStrideZ + u.pm * BM + (tid & 255)]; }
        __syncthreads();
#pragma unroll
        for (int hh = 0; hh < 2; ++hh)
#pragma unroll
            for (int i = 0; i < 2; ++i) voffA[hh][i] = (unsigned)idxl[hh * HALF + sR[i]] * (unsigned)(K * 2) + (unsigned)sC[i] * 2u;
    } else {
#pragma unroll
        for (int hh = 0; hh < 2; ++hh)
#pragma unroll
            for (int i = 0; i < 2; ++i) voffA[hh][i] = (TILED & 1) ? (unsigned)hh * (unsigned)(HALF * K * 2) + (unsigned)(sR[i] * BK + sC[i]) * 2u : (unsigned)((hh * HALF + sR[i]) * K + sC[i]) * 2u;
    }
#pragma unroll
    for (int hh = 0; hh < 2; ++hh)
#pragma unroll
        for (int i = 0; i < 2; ++i) voffN[hh][i] = voffA[hh][i];
    f32x4 acc[2][2][4][2];
#pragma unroll
    for (int a = 0; a < 2; ++a)
#pragma unroll
        for (int b = 0; b < 2; ++b)
#pragma unroll
            for (int m = 0; m < 4; ++m)
#pragma unroll
                for (int n = 0; n < 2; ++n) acc[a][b][m][n] = (f32x4){0.f, 0.f, 0.f, 0.f};
    bf16x8 At[4][2], B0[2][2], B1[2][2];
    auto k0t = [&](const Unit& u) -> size_t { return (SPLITK && u.kq >= 0) ? (size_t)(12 * u.kq - (u.kq == 3 ? 2 : 0)) : (size_t)0; };
    const char* cA = (const char*)(g.A + (size_t)cur.z * g.aStrideZ) + (GATHER ? (size_t)0 : (size_t)cur.pm * tstep) + k0t(cur) * kstepA;
    const char* cB = (const char*)(g.Bt + (size_t)cur.z * g.bStrideZ) + (size_t)cur.pn * tstep + k0t(cur) * kstepB;
    PG8_STAGE(PG8_SB(0, 0), cB, voffB); PG8_STAGE(PG8_SB(0, 1), cB + hstep, voffB); PG8_STAGE(PG8_SA(0, 0), cA, voffA[0]); PG8_STAGE(PG8_SA(0, 1), cA, voffA[1]);
    if (wr == 1) PG8_BAR;
    PG8_WAIT_V(2); PG8_BAR;
    PG8_STAGE(PG8_SB(1, 0), cB + kstepB, voffB); PG8_STAGE(PG8_SA(1, 0), cA + kstepA, voffA[0]); PG8_STAGE(PG8_SB(1, 1), cB + hstep + kstepB, voffB);
    PG8_WAIT_V(6); PG8_BAR;
    for (;;) {
        const bool has_next = S.next(ui + 1, nxt);
        const char* nA = has_next ? (const char*)(g.A + (size_t)nxt.z * g.aStrideZ) + (GATHER ? (size_t)0 : (size_t)nxt.pm * tstep) + k0t(nxt) * kstepA : cA;
        const char* nB = has_next ? (const char*)(g.Bt + (size_t)nxt.z * g.bStrideZ) + (size_t)nxt.pn * tstep + k0t(nxt) * kstepB : cB;
        const int nt = (SPLITK && cur.kq >= 0) ? (cur.kq < 2 ? 12 : 10) : ntf;
        const bool shortu = cur.pm >= SHORT_PM, do0 = (HALFM && cur.kq >= 0) ? cur.kq == 0 : (!shortu || wr == 0), do1 = (HALFM && cur.kq >= 0) ? cur.kq == 1 : !shortu;
        for (int t = 0; t < nt; t += 2) {
            const bool last = (t == nt - 2);
            const char* a1 = cA + (size_t)(t + 1) * kstepA;
            const char* a2 = last ? nA : cA + (size_t)(t + 2) * kstepA; const char* b2 = last ? nB : cB + (size_t)(t + 2) * kstepB;
            const char* a3 = a2 + kstepA; const char* b3 = b2 + kstepB;
            unsigned vs[2][2];
            if constexpr (GATHER) {
                if (last && has_next) {
#pragma unroll
                    for (int hh = 0; hh < 2; ++hh)
#pragma unroll
                        for (int i = 0; i < 2; ++i) voffN[hh][i] = (unsigned)idxl[(ui + 1) * 256 + hh * HALF + sR[i]] * (unsigned)(K * 2) + (unsigned)sC[i] * 2u;
                }
#pragma unroll
                for (int hh = 0; hh < 2; ++hh)
#pragma unroll
                    for (int i = 0; i < 2; ++i) vs[hh][i] = last ? voffN[hh][i] : voffA[hh][i];
            } else {
#pragma unroll
                for (int hh = 0; hh < 2; ++hh)
#pragma unroll
                    for (int i = 0; i < 2; ++i) vs[hh][i] = voffA[hh][i];
            }
            PG8_LDB(B0, 0, 0); PG8_LDB(B1, 0, 1); PG8_SCHED; PG8_LDA(At, 0, 0); PG8_STAGE(PG8_SA(1, 1), a1, voffA[1]);
            PG8_WAIT_V(8); PG8_WAIT_L(0); PG8_BAR; if (do0) { PG8_MMA(0, 0, At, B0); PG8_MMA(0, 1, At, B1); } PG8_BAR; PG8_SCHED;
            PG8_LDA(At, 0, 1); PG8_STAGE(PG8_SB(0, 0), b2, voffB); PG8_STAGE(PG8_SB(0, 1), b2 + hstep, voffB); PG8_STAGE(PG8_SA(0, 0), a2, vs[0]);
            PG8_WAIT_V(8); PG8_WAIT_L(0); PG8_BAR; if (do1) { PG8_MMA(1, 0, At, B0); PG8_MMA(1, 1, At, B1); } PG8_BAR; PG8_SCHED;
            PG8_LDB(B0, 1, 0); PG8_LDB(B1, 1, 1); PG8_SCHED; PG8_LDA(At, 1, 0); PG8_STAGE(PG8_SA(0, 1), a2, vs[1]);
            PG8_WAIT_V(8); PG8_WAIT_L(0); PG8_BAR; if (do0) { PG8_MMA(0, 0, At, B0); PG8_MMA(0, 1, At, B1); } PG8_BAR; PG8_SCHED;
            PG8_LDA(At, 1, 1); PG8_STAGE(PG8_SB(1, 0), b3, voffB); PG8_STAGE(PG8_SB(1, 1), b3 + hstep, voffB); PG8_STAGE(PG8_SA(1, 0), a3, vs[0]);
            PG8_WAIT_V(8); PG8_WAIT_L(0); PG8_BAR; if (do1) { PG8_MMA(1, 0, At, B0); PG8_MMA(1, 1, At, B1); } PG8_BAR; PG8_SCHED;
        }
        if (wr == 0) PG8_BAR;
        if constexpr (Epi::FUSED) E.fused(acc, cur, wr, wc, fr, fq, lds, tid); else E(acc, cur, wr, wc, fr, fq);
        if (!has_next) break;
#pragma unroll
        for (int a = 0; a < 2; ++a)
#pragma unroll
            for (int b = 0; b < 2; ++b)
#pragma unroll
                for (int m = 0; m < 4; ++m)
#pragma unroll
                    for (int n = 0; n < 2; ++n) acc[a][b][m][n] = (f32x4){0.f, 0.f, 0.f, 0.f};
        cur = nxt; cA = nA; cB = nB; ++ui;
#pragma unroll
        for (int hh = 0; hh < 2; ++hh)
#pragma unroll
            for (int i = 0; i < 2; ++i) voffA[hh][i] = voffN[hh][i];
        if (wr == 1) PG8_BAR;
    }
    PG8_WAIT_V(0);
    PG8_BAR;
#undef PG8_SA
#undef PG8_SB
#undef PG8_STAGE
#undef PG8_LDA
#undef PG8_LDB
#undef PG8_MMA
#undef PG8_WAIT_V
#undef PG8_WAIT_L
#undef PG8_BAR
#undef PG8_SCHED
}
}

constexpr int CVT_SCR = 16640;
__device__ __forceinline__ void cvt_item(const float* W, int K, int N, bf16_t* WT, int drow0, int k0, int n0, LAS float* scr, int lane) {
    f32x4 v[16];
    const int lr = lane >> 4, lc4 = (lane & 15) * 4;
#pragma unroll
    for (int i = 0; i < 16; ++i) v[i] = __builtin_nontemporal_load((const f32x4*)(W + (size_t)(k0 + 4 * i + lr) * N + n0 + lc4));
#pragma unroll
    for (int i = 0; i < 16; ++i) { LAS float* d = scr + (4 * i + lr) * 65 + lc4; d[0] = v[i][0]; d[1] = v[i][1]; d[2] = v[i][2]; d[3] = v[i][3]; }
    asm volatile("s_waitcnt lgkmcnt(0)" ::: "memory");
    const int c = lane & 7;
#pragma unroll
    for (int j = 0; j < 8; ++j) { const int n = (lane >> 3) + 8 * j; const LAS float* s = scr + (8 * c) * 65 + n;
        u32x4 o; o.x = cvt_pk_bf16(s[0 * 65], s[1 * 65]); o.y = cvt_pk_bf16(s[2 * 65], s[3 * 65]); o.z = cvt_pk_bf16(s[4 * 65], s[5 * 65]); o.w = cvt_pk_bf16(s[6 * 65], s[7 * 65]);
        __builtin_nontemporal_store(o, (u32x4*)(WT + ((size_t)((drow0 + n) >> 7) * (K >> 6) + (k0 >> 6)) * 8192 + ((drow0 + n) & 127) * 64 + 8 * c)); }
    asm volatile("s_waitcnt lgkmcnt(0)" ::: "memory");
}
__device__ __forceinline__ void cvt_plain(const float* W, int K, int N, bf16_t* WT, int item, LAS float* scr, int lane) {
    const int nblk = N / 64, kb = item / nblk, nb = item % nblk;
    cvt_item(W, K, N, WT, nb * 64, kb * 64, nb * 64, scr, lane);
}

struct CvtDense { const float *win0, *wout0, *win1, *wout1; bf16_t *win0t, *wout0t, *win1t, *wout1t; };
__device__ __forceinline__ void phase_cvt_dense(LAS unsigned char* lds, const CvtDense a) {
    const int tid_ = tidx(), wave = tid_ >> 6, lane = tid_ & 63;
    LAS float* scr = (LAS float*)(lds + wave * CVT_SCR);
    const int gw = blockIdx.x * 8 + wave, NGW = gridDim.x * 8;
    constexpr int I0 = (D / 64) * (ABIN / 64), I1 = (D / 64) * (D / 64), I2 = (D / 64) * (RIN / 64), I3 = (2048 / 64) * (D / 64);
    for (int it = gw; it < I0 + I1 + I2 + I3; it += NGW) {
        int r = it;
        if (r < I0) { cvt_plain(a.win0, D, ABIN, a.win0t, r, scr, lane); continue; } r -= I0;
        if (r < I1) { cvt_plain(a.wout0, D, D, a.wout0t, r, scr, lane); continue; } r -= I1;
        if (r < I2) { cvt_plain(a.win1, D, RIN, a.win1t, r, scr, lane); continue; } r -= I2;
        cvt_plain(a.wout1, 2048, D, a.wout1t, r, scr, lane);
    }
}
struct CvtMoe { const float *wg, *wu, *wd; bf16_t *gu, *dn; };
__device__ __forceinline__ void phase_cvt_moe(LAS unsigned char* lds, const CvtMoe a) {
    const int tid_ = tidx(), wave = tid_ >> 6, lane = tid_ & 63;
    LAS float* scr = (LAS float*)(lds + wave * CVT_SCR);
    const int gw = blockIdx.x * 8 + wave, NGW = gridDim.x * 8;
    constexpr int IG = (D / 64) * (FF / 64), ID = (FF / 64) * (D / 64);
    for (int it = gw; it < 2 * NE * (2 * IG + ID); it += NGW) {
        const int e = it / (2 * IG + ID); int r = it % (2 * IG + ID);
        if (r < 2 * IG) { const int up = r / IG; r %= IG; const int nblk = FF / 64, kb = r / nblk, nb = r % nblk, n0 = nb * 64;
            cvt_item((up ? a.wu : a.wg) + (size_t)e * D * FF, D, FF, a.gu + (size_t)e * 2 * FF * D, (n0 / 128) * 256 + up * 128 + (n0 % 128), kb * 64, n0, scr, lane); }
        else { r -= 2 * IG; const int nblk = D / 64, kb = r / nblk, nb = r % nblk; cvt_item(a.wd + (size_t)e * FF * D, FF, D, a.dn + (size_t)e * D * FF, nb * 64, kb * 64, nb * 64, scr, lane); }
    }
}

#define XB_TMO      128
#define XB_XCNT(j)  (256  + 64 * (j))
#define XB_XSUB(j)  (1280 + 64 * (j))
#define XB_XGEN(j)  (2304 + 64 * (j))
#define XB_TOP      3328
#define XB_TOPGEN   3392
#define XCD_BAR_WORDS 3456
#define XB_SPIN_CAP (1u << 18)

__device__ __forceinline__ unsigned xb_ld(unsigned* p)              { return __hip_atomic_load(p, __ATOMIC_RELAXED, __HIP_MEMORY_SCOPE_AGENT); }
__device__ __forceinline__ unsigned xb_add(unsigned* p, unsigned v) { return __hip_atomic_fetch_add(p, v, __ATOMIC_RELAXED, __HIP_MEMORY_SCOPE_AGENT); }
__device__ __forceinline__ unsigned xb_xcc_id() { return (unsigned)__builtin_amdgcn_s_getreg((3 << 11) | 20) & 0xFu; }
#define XB_SPIN(cond, bar) do { unsigned _sp = 0; while (cond) { __builtin_amdgcn_s_sleep(1); \
    if ((++_sp & 255u) == 0u) { if (xb_ld(&(bar)[XB_TMO])) break; if (_sp > XB_SPIN_CAP) { atomicAdd(&(bar)[XB_TMO], 1u); break; } } } } while (0)

struct XcdBarrier { unsigned* bar; unsigned x; volatile LAS unsigned* st; };

__device__ __forceinline__ XcdBarrier xcd_barrier_post(unsigned* bar, volatile LAS unsigned* st) {
    XcdBarrier b; b.bar = bar; b.x = xb_xcc_id(); b.st = st;
    if (threadIdx.x == 0) (void)xb_add(&bar[XB_XCNT(b.x)], 1u);
    return b;
}
__device__ __forceinline__ void xcd_barrier_complete(unsigned* bar, unsigned x, unsigned& nloc, unsigned& nx) {
    const unsigned G = gridDim.x * gridDim.y * gridDim.z;
    unsigned sum, cnt, mine, sp = 0u;
    for (;;) {
        sum = 0u; cnt = 0u; mine = 0u;
#pragma unroll
        for (unsigned j = 0; j < 16; ++j) { const unsigned c = xb_ld(&bar[XB_XCNT(j)]); sum += c; cnt += (c > 0u) ? 1u : 0u; mine = (j == x) ? c : mine; }
        if (sum == G) break;
        __builtin_amdgcn_s_sleep(1);
        if ((++sp & 255u) == 0u) { if (xb_ld(&bar[XB_TMO])) break; if (sp > XB_SPIN_CAP) { atomicAdd(&bar[XB_TMO], 1u); break; } }
    }
    nloc = mine > 0u ? mine : 1u; nx = cnt > 0u ? cnt : 1u;
}
__device__ __forceinline__ void xcd_barrier(const XcdBarrier& b) {
    asm volatile("s_waitcnt vmcnt(0)" ::: "memory");
    __syncthreads();
    if (threadIdx.x == 0) {
        unsigned* bar = b.bar;
        __builtin_amdgcn_s_waitcnt(0);
        unsigned nloc = b.st[0], nx = b.st[1];
        if (nloc == 0u) { xcd_barrier_complete(bar, b.x, nloc, nx); b.st[0] = nloc; b.st[1] = nx; }
        const unsigned old = xb_add(&bar[XB_XSUB(b.x)], 1u);
        const unsigned gen = old / nloc;
        if (old + 1u == (gen + 1u) * nloc) {
            __builtin_amdgcn_fence(__ATOMIC_RELEASE, "agent");
            asm volatile("s_waitcnt vmcnt(0)" ::: "memory");
            const unsigned og = xb_add(&bar[XB_TOP], 1u);
            const unsigned tg = og / nx;
            if (og + 1u == (tg + 1u) * nx) xb_add(&bar[XB_TOPGEN], 1u);
            else XB_SPIN(xb_ld(&bar[XB_TOPGEN]) == tg, bar);
            __builtin_amdgcn_fence(__ATOMIC_ACQUIRE, "agent");
            xb_add(&bar[XB_XGEN(b.x)], 1u);
            asm volatile("s_waitcnt vmcnt(0)" ::: "memory");
        } else {
            XB_SPIN(xb_ld(&bar[XB_XGEN(b.x)]) == gen, bar);
            __builtin_amdgcn_fence(__ATOMIC_ACQUIRE, "agent");
            asm volatile("s_waitcnt vmcnt(0)" ::: "memory");
        }
    }
    __syncthreads();
}

constexpr size_t GUT_L = (size_t)NE * 2 * FF * D, DNT_L = (size_t)NE * D * FF;
constexpr size_t al256(size_t b) { return (b + 255) & ~(size_t)255; }
constexpr size_t OFF_BAR = 0;
constexpr size_t OFF_PCNT = OFF_BAR + al256((size_t)3456 * 4);
constexpr size_t ZERO_BYTES = (OFF_PCNT - OFF_BAR) + (size_t)2 * 128 * 256;
constexpr size_t OFF_X = OFF_BAR + al256(ZERO_BYTES);
constexpr size_t OFF_HB = OFF_X + al256((size_t)MT * D * 4);
constexpr size_t OFF_R2 = OFF_HB + al256((size_t)MT * D * 2);
constexpr size_t OFF_VN = OFF_R2 + al256((size_t)NE * MEXP * FF * 2);
constexpr size_t OFF_ABB = OFF_VN + al256((size_t)MT * 512 * 4);
constexpr size_t OFF_A2B = OFF_ABB + al256((size_t)MT * D * 2);
constexpr size_t OFF_YEB = OFF_A2B + al256((size_t)ML * 2048 * 2);
constexpr size_t OFF_O = OFF_YEB + al256((size_t)NE * MEXP * D * 2);
constexpr size_t OFF_WIN0 = OFF_O + al256((size_t)2 * ML * 2048 * 4);
constexpr size_t OFF_WOUT0 = OFF_WIN0 + al256((size_t)ABIN * D * 2);
constexpr size_t OFF_WIN1 = OFF_WOUT0 + al256((size_t)D * D * 2);
constexpr size_t OFF_WOUT1 = OFF_WIN1 + al256((size_t)RIN * D * 2);
constexpr size_t OFF_GUT = OFF_WOUT1 + al256((size_t)D * 2048 * 2);
constexpr size_t OFF_DNT = OFF_GUT + al256(2 * GUT_L * 2);
constexpr size_t OFF_MOD = OFF_DNT + al256(2 * DNT_L * 2);
constexpr size_t OFF_AFFL = OFF_MOD + al256((size_t)2 * 3 * MODW * 4);
constexpr size_t OFF_AFFC = OFF_AFFL + al256((size_t)NB * NE * SEQ * 4);
constexpr size_t OFF_GATE = OFF_AFFC + al256((size_t)NB * NE * CTX * 4);
constexpr size_t OFF_RIDX = OFF_GATE + al256((size_t)NE * MEXP * 4);
constexpr size_t OFF_SLOT = OFF_RIDX + al256((size_t)NE * MEXP * 4);
constexpr size_t OFF_ROPE = OFF_SLOT + al256((size_t)MT * 16 * 4);
constexpr size_t OFF_ROPE2 = OFF_ROPE + al256((size_t)128 * 64 * 8);
constexpr size_t OFF_SGW = OFF_ROPE2 + al256((size_t)64 * 128 * 8);
constexpr size_t WS_END = OFF_SGW + al256((size_t)8 * 128 * 128 * 2);
constexpr size_t R2_Q = OFF_R2, R2_KN = R2_Q + (size_t)ML * 1024 * 2, R2_KT = R2_KN + (size_t)ML * 1024 * 2, R2_VT = R2_KT + (size_t)1024 * MT * 2;
static_assert(R2_VT + (size_t)2048 * MT * 2 <= OFF_VN, "R2 map");
constexpr size_t R2_QK0 = OFF_R2, R2_U0 = R2_QK0 + (size_t)MT * 1024 * 2, R2_VT0 = R2_U0 + (size_t)MT * 512 * 2, R2_GVT0 = R2_VT0 + (size_t)512 * MT * 2;
constexpr size_t O_OB = OFF_O, O_ATT = O_OB + (size_t)2 * ML * 2048 * 2, O_GS = O_ATT + (size_t)2 * 2 * 4 * 64 * 128 * 128 * 2;
static_assert(O_GS + (size_t)ML * 2048 * 2 <= OFF_WIN0, "O map");
struct Params {
    const float *x, *c, *ctx, *c_ctx, *ada_w, *ada_b, *norm1_g, *norm2_g, *ab_w_in, *ab_w_out, *na_rpb, *sgu_norm_g, *sgu_w, *sgu_b,
                *ret_w_in, *ret_w_out, *ret_decay, *moe_router, *moe_w_gate, *moe_w_up, *moe_w_down, *final_g;
    float* out; char* ws;
};
#define WSP(T, off) ((T*)(p.ws + (off)))

__device__ __forceinline__ float fq_sum(float s) {
    { const auto r = __builtin_amdgcn_permlane16_swap(__float_as_uint(s), __float_as_uint(s), false, false); s = __uint_as_float(r[0]) + __uint_as_float(r[1]); }
    { const auto r = __builtin_amdgcn_permlane32_swap(__float_as_uint(s), __float_as_uint(s), false, false); s = __uint_as_float(r[0]) + __uint_as_float(r[1]); }
    return s;
}
template <int LAYER> struct EpiResNorm {
    static constexpr bool PERM = true, FUSED = true;
    char* ws; const float* g2; const float* wrt; const float* srcL; const float* srcC;
    __device__ __forceinline__ void fused(f32x4 (&acc)[2][2][4][2], const pg8::Unit& u_, int wr_, int wc_, int fr_, int fq_, LAS unsigned char* lds, int tid_) const {
        int wr = wr_, wc = wc_, fr = fr_, fq = fq_, tid = tid_; asm volatile("" : "+s"(wr), "+s"(wc), "+v"(fr), "+v"(fq), "+v"(tid));
        using pg8::BM; using pg8::HALF; using pg8::pack8;
        pg8::Unit u = u_; asm volatile("" : "+s"(u.pm), "+s"(u.pn));
        bf16_t* X = (bf16_t*)(ws + OFF_X); bf16_t* HB = (bf16_t*)(ws + OFF_HB); const float* mod = (const float*)(ws + OFF_MOD) + LAYER * 3 * MODW; const float* gate = mod + 2 * D;
        float* xbuf = (float*)(ws + OFF_VN) + (1u << 18); unsigned* cnt = (unsigned*)(ws + OFF_PCNT) + LAYER * 128 * 64;
        const bool isctx = u.pm >= 64;
        const int wid = __builtin_amdgcn_readfirstlane(tid >> 6), lane = tid & 63;
        const int row0 = u.pm * BM + wr * 64 + fr, col0 = u.pn * BM + wc * 32 + 8 * fq, bidx = isctx ? 2 : u.pm / 32;
        {   const float* gp = gate + bidx * MODW + col0; f32x4 gv[2][2];
#pragma unroll
            for (int bj = 0; bj < 2; ++bj)
#pragma unroll
                for (int n = 0; n < 2; ++n) gv[bj][n] = *(const f32x4*)(gp + bj * HALF + 4 * n);
#pragma unroll
            for (int ai = 0; ai < 2; ++ai)
#pragma unroll
                for (int m = 0; m < 4; ++m) { bf16_t* rowp = X + (size_t)(row0 + ai * HALF + m * 16) * D + col0;
#pragma unroll
                    for (int bj = 0; bj < 2; ++bj) { f32x4 s0, s1;
                        if (LAYER == 0) { const float* sp = (isctx ? srcC + (size_t)(row0 - ML + ai * HALF + m * 16) * D : srcL + (size_t)(row0 + ai * HALF + m * 16) * D) + col0 + bj * HALF;
                            s0 = __builtin_nontemporal_load((const f32x4*)sp); s1 = __builtin_nontemporal_load((const f32x4*)(sp + 4)); }
                        else { const u32x4 xb = *(const u32x4*)(rowp + bj * HALF);
                            s0 = (f32x4){__uint_as_float(xb.x << 16), __uint_as_float(xb.x & 0xffff0000u), __uint_as_float(xb.y << 16), __uint_as_float(xb.y & 0xffff0000u)};
                            s1 = (f32x4){__uint_as_float(xb.z << 16), __uint_as_float(xb.z & 0xffff0000u), __uint_as_float(xb.w << 16), __uint_as_float(xb.w & 0xffff0000u)}; }
                        const u32x4 w = pack8(s0 + gv[bj][0] * acc[ai][bj][m][0], s1 + gv[bj][1] * acc[ai][bj][m][1]);
                        *(u32x4*)(rowp + bj * HALF) = w;
                        acc[ai][bj][m][0] = (f32x4){__uint_as_float(w.x << 16), __uint_as_float(w.x & 0xffff0000u), __uint_as_float(w.y << 16), __uint_as_float(w.y & 0xffff0000u)};
                        acc[ai][bj][m][1] = (f32x4){__uint_as_float(w.z << 16), __uint_as_float(w.z & 0xffff0000u), __uint_as_float(w.w << 16), __uint_as_float(w.w & 0xffff0000u)}; } }
        }
        asm volatile("s_waitcnt vmcnt(0)" ::: "memory"); __builtin_amdgcn_s_barrier(); asm volatile("" ::: "memory");
        LAS bf16_t* WLh = (LAS bf16_t*)lds;
        LAS bf16_t* WLl = WLh + 16 * 264;
        LAS float* CSH = (LAS float*)(WLl + 16 * 264);
        LAS float* P = CSH + 64;
        LAS float* Sr = P + 256 * 4 * 20;
        LAS float* LG = Sr + 256;
        LAS unsigned* flag = (LAS unsigned*)(LG + 1024);
        const float* mrow = mod + bidx * MODW;
        for (int idx = tid; idx < 4096; idx += NTHR) { const int e = idx & 15, c = idx >> 4, cg = u.pn * BM + c; const float wv = wrt[cg * 16 + e] * g2[cg] * (mrow[4 * D + cg] + 1.f);
            const bf16_t hi = f2bf(wv); WLh[e * 264 + c] = hi; WLl[e * 264 + c] = f2bf(wv - bf2f(hi)); }
        {
            const int e = tid & 15, cp = tid >> 4; float s = 0.f;
#pragma unroll 8
            for (int k = 0; k < 32; ++k) { const int c = cp * 32 + k; s += mrow[3 * D + c] * wrt[c * 16 + e]; }
            Sr[cp * 16 + e] = s;
        }
        asm volatile("s_waitcnt lgkmcnt(0)" ::: "memory"); __builtin_amdgcn_s_barrier(); asm volatile("" ::: "memory");
        if (tid < 16) { float s = 0.f;
#pragma unroll
            for (int q = 0; q < 32; ++q) s += Sr[q * 16 + tid];
            CSH[tid] = s; }
        {   bf16x8 Ah[2], Al[2];
#pragma unroll
            for (int bj = 0; bj < 2; ++bj) { Ah[bj] = *(const LAS bf16x8*)(WLh + fr * 264 + bj * HALF + wc * 32 + 8 * fq); Al[bj] = *(const LAS bf16x8*)(WLl + fr * 264 + bj * HALF + wc * 32 + 8 * fq); }
#pragma unroll
            for (int ai = 0; ai < 2; ++ai)
#pragma unroll
                for (int m = 0; m < 4; ++m) { float s = 0.f; f32x4 pe = {0.f, 0.f, 0.f, 0.f};
#pragma unroll
                    for (int bj = 0; bj < 2; ++bj) {
#pragma unroll
                        for (int n = 0; n < 2; ++n) { const f32x4 x = acc[ai][bj][m][n]; s += (x[0] * x[0] + x[1] * x[1]) + (x[2] * x[2] + x[3] * x[3]); }
                        const bf16x8 xb = __builtin_bit_cast(bf16x8, pack8(acc[ai][bj][m][0], acc[ai][bj][m][1]));
                        pe = __builtin_amdgcn_mfma_f32_16x16x32_bf16(Ah[bj], xb, pe, 0, 0, 0); pe = __builtin_amdgcn_mfma_f32_16x16x32_bf16(Al[bj], xb, pe, 0, 0, 0); }
                    s = fq_sum(s);
                    LAS float* pr = P + ((ai * HALF + wr * 64 + m * 16 + fr) * 4 + wc) * 20;
                    *(LAS f32x4*)(pr + 4 * fq) = pe;
                    if (fq == 0) pr[16] = s; }
        }
        asm volatile("s_waitcnt lgkmcnt(0)" ::: "memory"); __builtin_amdgcn_s_barrier(); asm volatile("" ::: "memory");
        float* slot = xbuf + ((size_t)u.pm * BM * 4 + u.pn) * 20;
        for (int idx = tid; idx < 256 * 17; idx += NTHR) { const int row = idx / 17, k = idx - row * 17;
            const float s = (P[(row * 4 + 0) * 20 + k] + P[(row * 4 + 1) * 20 + k]) + (P[(row * 4 + 2) * 20 + k] + P[(row * 4 + 3) * 20 + k]);
            __hip_atomic_store(slot + (size_t)row * 80 + k, s, __ATOMIC_RELAXED, __HIP_MEMORY_SCOPE_AGENT); }
        asm volatile("s_waitcnt vmcnt(0)" ::: "memory");
        if (lane == 0) __hip_atomic_fetch_add(cnt + 64 * u.pm, 1u, __ATOMIC_RELAXED, __HIP_MEMORY_SCOPE_AGENT);
        if (wid == 0) { bool dead = false; unsigned sp = 0u;
            for (;;) { if ((unsigned)__builtin_amdgcn_readfirstlane(__hip_atomic_load(cnt + 64 * u.pm, __ATOMIC_RELAXED, __HIP_MEMORY_SCOPE_AGENT)) >= 32u) break;
                if (++sp > (1u << 22)) { dead = true; break; }
                __builtin_amdgcn_s_sleep(2); }
            __builtin_amdgcn_fence(__ATOMIC_ACQUIRE, "agent");
            if (lane == 0) flag[0] = dead ? 1u : 0u; }
        asm volatile("s_waitcnt vmcnt(0) lgkmcnt(0)" ::: "memory"); __builtin_amdgcn_s_barrier(); asm volatile("" ::: "memory");
        const bool bad = flag[0] != 0u;
        const float* pan = xbuf + (size_t)u.pm * BM * 80;
        if (tid < 256) { const float* sl = pan + (size_t)tid * 80 + 16;
            const float ss = (__hip_atomic_load(sl, __ATOMIC_RELAXED, __HIP_MEMORY_SCOPE_AGENT) + __hip_atomic_load(sl + 20, __ATOMIC_RELAXED, __HIP_MEMORY_SCOPE_AGENT))
                           + (__hip_atomic_load(sl + 40, __ATOMIC_RELAXED, __HIP_MEMORY_SCOPE_AGENT) + __hip_atomic_load(sl + 60, __ATOMIC_RELAXED, __HIP_MEMORY_SCOPE_AGENT));
            Sr[tid] = rsqrtf(ss * (1.f / D) + EPS); }
        asm volatile("s_waitcnt lgkmcnt(0)" ::: "memory"); __builtin_amdgcn_s_barrier(); asm volatile("" ::: "memory");
#pragma unroll
        for (int q = 0; q < 2; ++q) { const int item = tid + q * NTHR, rl = item >> 4, e = item & 15, row = 64 * u.pn + rl; const float* sl = pan + (size_t)row * 80 + e;
            const float s = (__hip_atomic_load(sl, __ATOMIC_RELAXED, __HIP_MEMORY_SCOPE_AGENT) + __hip_atomic_load(sl + 20, __ATOMIC_RELAXED, __HIP_MEMORY_SCOPE_AGENT))
                          + (__hip_atomic_load(sl + 40, __ATOMIC_RELAXED, __HIP_MEMORY_SCOPE_AGENT) + __hip_atomic_load(sl + 60, __ATOMIC_RELAXED, __HIP_MEMORY_SCOPE_AGENT));
            LG[rl * 16 + e] = Sr[row] * s + CSH[e]; }
        asm volatile("s_waitcnt lgkmcnt(0)" ::: "memory"); __builtin_amdgcn_s_barrier(); asm volatile("" ::: "memory");
        if (tid < 64) { float a[16]; float mx = -3.0e38f;
#pragma unroll
            for (int e = 0; e < 16; ++e) { a[e] = LG[tid * 16 + e]; mx = fmaxf(mx, a[e]); }
            float sum = 0.f;
#pragma unroll
            for (int e = 0; e < 16; ++e) { a[e] = expf(a[e] - mx); sum += a[e]; }
            const float inv = 1.f / sum; const int row = u.pm * BM + 64 * u.pn + tid;
            float* ap = isctx ? (float*)(ws + OFF_AFFC) + (size_t)((row - ML) / CTX) * 16 * CTX + (row - ML) % CTX : (float*)(ws + OFF_AFFL) + (size_t)(row / SEQ) * 16 * SEQ + row % SEQ;
            const int es = isctx ? CTX : SEQ;
#pragma unroll
            for (int e = 0; e < 16; ++e) ap[(size_t)e * es] = bad ? __builtin_nanf("") : a[e] * inv; }
#pragma unroll
        for (int bj = 0; bj < 2; ++bj) { f32x4 G[2], SH[2];
#pragma unroll
            for (int n = 0; n < 2; ++n) { const int c = col0 + bj * HALF + 4 * n; const f32x4 gg = *(const f32x4*)(g2 + c), sc = *(const f32x4*)(mrow + 4 * D + c);
                G[n] = gg * (sc + 1.f); SH[n] = *(const f32x4*)(mrow + 3 * D + c); }
#pragma unroll
            for (int ai = 0; ai < 2; ++ai)
#pragma unroll
                for (int m = 0; m < 4; ++m) { const int rl = ai * HALF + wr * 64 + m * 16 + fr; const float r = bad ? __builtin_nanf("") : Sr[rl];
                    *(u32x4*)(HB + (size_t)(u.pm * BM + rl) * D + col0 + bj * HALF) = pack8(acc[ai][bj][m][0] * r * G[0] + SH[0], acc[ai][bj][m][1] * r * G[1] + SH[1]); }
            asm volatile("" ::: "memory"); }
    }
    __device__ __forceinline__ void operator()(const f32x4 (&)[2][2][4][2], const pg8::Unit&, int, int, int, int) const {}
};


__device__ __forceinline__ void lds_fence() { asm volatile("s_waitcnt lgkmcnt(0)" ::: "memory"); }

__device__ __forceinline__ void ph_prologue(const int vc, const Params& p, LAS unsigned char* lds) {
    const int tid = tidx(), wave = tid >> 6, lane = tid & 63;
    if (blockIdx.x < 192) {
        LAS float* s = (LAS float*)(lds + LDS_STAGE); LAS float* red = (LAS float*)(lds + LDS_STAGE + 12288);
        const int layer = blockIdx.x / 96, n0 = (blockIdx.x % 96) * 64;
        for (int i = tid; i < 3072; i += NTHR) { const int r = i >> 10, k = i & 1023; s[i] = silu_f(r < 2 ? p.c[r * D + k] : p.c_ctx[k]); }
        __syncthreads();
        const float* w = p.ada_w + (size_t)layer * D * MODW + n0 + lane;
        float a0 = 0.f, a1 = 0.f, a2 = 0.f;
#pragma unroll 1
        for (int k0 = wave * 128; k0 < wave * 128 + 128; k0 += 32) {
            float wv[32];
#pragma unroll
            for (int i = 0; i < 32; ++i) wv[i] = __builtin_nontemporal_load(w + (size_t)(k0 + i) * MODW);
#pragma unroll
            for (int i = 0; i < 32; ++i) { a0 += s[k0 + i] * wv[i]; a1 += s[1024 + k0 + i] * wv[i]; a2 += s[2048 + k0 + i] * wv[i]; }
        }
        red[(wave * 3 + 0) * 64 + lane] = a0; red[(wave * 3 + 1) * 64 + lane] = a1; red[(wave * 3 + 2) * 64 + lane] = a2;
        __syncthreads();
        if (tid < 192) { const int r = tid >> 6; float sum = 0.f;
#pragma unroll
            for (int q = 0; q < 8; ++q) sum += red[(q * 3 + r) * 64 + lane];
            WSP(float, OFF_MOD)[((size_t)layer * 3 + r) * MODW + n0 + lane] = sum + p.ada_b[layer * MODW + n0 + lane]; }
        __syncthreads();
    }
    { const int i = blockIdx.x * NTHR + tid;
      if (i < 128 * 64) { const int pos = i >> 6, f = i & 63; const float inv = 1.0f / powf(10000.f, (float)(2 * f) / 128.f); const float ang = (float)pos * inv; const f32x2 cs = (f32x2){cosf(ang), sinf(ang)}; WSP(f32x2, OFF_ROPE)[i] = cs; WSP(f32x2, OFF_ROPE2)[f * 128 + pos] = cs; } }
    for (int i = blockIdx.x * NTHR + tid; i < 8 * 128 * 128; i += gridDim.x * NTHR) { const int g = i >> 14, pp = (i >> 7) & 127, q = i & 127;
        WSP(bf16_t, OFF_SGW)[(((g * 4 + (pp >> 5)) * 8 + (q >> 4)) * 64 + (pp & 31) + 32 * ((q >> 3) & 1)) * 8 + (q & 7)] = f2bf(p.sgu_w[i]); }
    phase_cvt_dense(lds, CvtDense{p.ab_w_in, p.ab_w_out, p.ret_w_in, p.ret_w_out, WSP(bf16_t, OFF_WIN0), WSP(bf16_t, OFF_WOUT0), WSP(bf16_t, OFF_WIN1), WSP(bf16_t, OFF_WOUT1)});
    phase_cvt_moe(lds, CvtMoe{p.moe_w_gate, p.moe_w_up, p.moe_w_down, WSP(bf16_t, OFF_GUT), WSP(bf16_t, OFF_DNT)});
}

__device__ __forceinline__ void row_load(const float* xr, int lane, f32x4 (&v)[4]) {
#pragma unroll
    for (int j = 0; j < 4; ++j) v[j] = ((const f32x4*)xr)[lane + 64 * j];
}
__device__ __forceinline__ void row_load_b(const bf16_t* xr, int lane, f32x4 (&v)[4]) {
#pragma unroll
    for (int j = 0; j < 4; ++j) { const u32x2 y = ((const u32x2*)xr)[lane + 64 * j];
        v[j] = (f32x4){__uint_as_float(y.x << 16), __uint_as_float(y.x & 0xffff0000u), __uint_as_float(y.y << 16), __uint_as_float(y.y & 0xffff0000u)}; }
}
__device__ __forceinline__ void row_store_b(bf16_t* xr, int lane, const f32x4 (&v)[4]) {
#pragma unroll
    for (int j = 0; j < 4; ++j) { u32x2 w; w.x = cvt_pk_bf16(v[j][0], v[j][1]); w.y = cvt_pk_bf16(v[j][2], v[j][3]); ((u32x2*)xr)[lane + 64 * j] = w; }
}
__device__ __forceinline__ float row_rms(const f32x4 (&v)[4]) {
    float ss = 0.f;
#pragma unroll
    for (int j = 0; j < 4; ++j) ss += (v[j][0] * v[j][0] + v[j][1] * v[j][1]) + (v[j][2] * v[j][2] + v[j][3] * v[j][3]);
    return rsqrtf(wave_sum(ss) * (1.f / D) + EPS);
}
__device__ __forceinline__ void row_mod_store(const f32x4 (&v)[4], float r, const float* g, const float* shift, const float* scale, bf16_t* hrow, int lane, f32x4 (&o)[4]) {
#pragma unroll
    for (int j = 0; j < 4; ++j) { const int c4 = lane + 64 * j;
        const f32x4 gg = ((const f32x4*)g)[c4], sc = ((const f32x4*)scale)[c4], sh = ((const f32x4*)shift)[c4];
        o[j] = v[j] * r * gg * (sc + 1.f) + sh;
        u32x2 w; w.x = cvt_pk_bf16(o[j][0], o[j][1]); w.y = cvt_pk_bf16(o[j][2], o[j][3]);
        ((u32x2*)hrow)[c4] = w; }
}

template <bool ROUTER, bool L0SRC>
__device__ __forceinline__ void ph_normmod(const int vc, const Params& p, LAS unsigned char* lds, int layer, int rows, const float* g, int shiftOff, int scaleOff) {
    const int tid = tidx(), wave = tid >> 6, lane = tid & 63;
    const int gw = vc * 8 + wave, NGW = gridDim.x * 8;
    LAS float* wl = (LAS float*)lds;
    if constexpr (ROUTER) {
        const float* wr = p.moe_router + (size_t)layer * D * NE;
        for (int i = tid; i < D * NE; i += NTHR) wl[(i & 15) * D + (i >> 4)] = wr[i];
        __syncthreads();
    }
    const float* modl = WSP(float, OFF_MOD) + (size_t)layer * 3 * MODW;
    f32x4 vn[4];
    auto load_row = [&](int row, f32x4 (&d)[4]) { if (L0SRC) row_load(row < ML ? p.x + (size_t)row * D : p.ctx + (size_t)(row - ML) * D, lane, d); else row_load_b(WSP(bf16_t, OFF_X) + (size_t)row * D, lane, d); };
    if (gw < rows) load_row(gw, vn);
    for (int row = gw; row < rows; row += NGW) {
        f32x4 v[4], o[4];
#pragma unroll
        for (int j = 0; j < 4; ++j) v[j] = vn[j];
        load_row(row + NGW < rows ? row + NGW : row, vn);
        const float r = row_rms(v);
        const float* m = modl + (row < ML ? row / SEQ : 2) * MODW;
        row_mod_store(v, r, g, m + shiftOff, m + scaleOff, WSP(bf16_t, OFF_HB) + (size_t)row * D, lane, o);
        if constexpr (ROUTER) {
            float acc[16];
#pragma unroll
            for (int e = 0; e < 16; ++e) { float a = 0.f;
#pragma unroll
                for (int j = 0; j < 4; ++j) { const f32x4 w4 = *(const LAS f32x4*)(wl + e * D + 4 * lane + 256 * j); a += (o[j][0] * w4[0] + o[j][1] * w4[1]) + (o[j][2] * w4[2] + o[j][3] * w4[3]); }
                acc[e] = a;
                if ((e & 3) == 3) asm volatile("" ::: "memory"); }
            float a8[8], a4[4], a2[2], a1;
            { const bool hi = lane & 32;
#pragma unroll
              for (int i = 0; i < 8; ++i) { const float send = hi ? acc[i] : acc[i + 8], keep = hi ? acc[i + 8] : acc[i]; a8[i] = keep + __shfl_xor(send, 32); } }
            { const bool hi = lane & 16;
#pragma unroll
              for (int i = 0; i < 4; ++i) { const float send = hi ? a8[i] : a8[i + 4], keep = hi ? a8[i + 4] : a8[i]; a4[i] = keep + __shfl_xor(send, 16); } }
            { const bool hi = lane & 8;
#pragma unroll
              for (int i = 0; i < 2; ++i) { const float send = hi ? a4[i] : a4[i + 2], keep = hi ? a4[i + 2] : a4[i]; a2[i] = keep + __shfl_xor(send, 8); } }
            { const bool hi = lane & 4; const float send = hi ? a2[0] : a2[1], keep = hi ? a2[1] : a2[0]; a1 = keep + __shfl_xor(send, 4); }
            a1 += __shfl_xor(a1, 2); a1 += __shfl_xor(a1, 1);
            float mx = a1;
#pragma unroll
            for (int of = 4; of <= 32; of <<= 1) mx = fmaxf(mx, __shfl_xor(mx, of));
            const float ex = expf(a1 - mx); float sum = ex;
#pragma unroll
            for (int of = 4; of <= 32; of <<= 1) sum += __shfl_xor(sum, of);
            const float a = ex / sum;
            if ((lane & 3) == 0) { const int e = lane >> 2;
                if (row < ML) WSP(float, OFF_AFFL)[((size_t)(row / SEQ) * 16 + e) * SEQ + (row % SEQ)] = a;
                else WSP(float, OFF_AFFC)[((size_t)((row - ML) / CTX) * 16 + e) * CTX + ((row - ML) % CTX)] = a; }
        }
    }
}

template <int VPT>
__device__ __forceinline__ void topk_list(const Params& p, LAS unsigned char* lds, const float* a, int N, int cap, int rowbase, int mbase, int e) {
    const int tid = tidx(), wave = tid >> 6, lane = tid & 63;
    LAS unsigned* hist = (LAS unsigned*)lds; LAS unsigned* sc = hist + 256; LAS unsigned* wsum = hist + 272;
    const bool active = tid * VPT < N;
    unsigned k[VPT];
#pragma unroll
    for (int j = 0; j < VPT; ++j) k[j] = active ? __float_as_uint(a[tid * VPT + j]) << 2 : 0u;
    unsigned prefix = 0u, mask = 0u; int need = cap;
#pragma unroll 1
    for (int pass = 0; pass < 4; ++pass) {
        const int shift = 24 - 8 * pass;
        if (tid < 256) hist[tid] = 0u;
        __syncthreads();
        if (active) {
#pragma unroll
            for (int j = 0; j < VPT; ++j) if ((k[j] & mask) == prefix) __hip_atomic_fetch_add(&hist[(k[j] >> shift) & 255u], 1u, __ATOMIC_RELAXED, __HIP_MEMORY_SCOPE_WORKGROUP);
        }
        __syncthreads();
        if (wave == 0) {
            const int c0 = hist[4 * lane], c1 = hist[4 * lane + 1], c2 = hist[4 * lane + 2], c3 = hist[4 * lane + 3], tot = c0 + c1 + c2 + c3;
            int incl = tot;
#pragma unroll
            for (int of = 1; of < 64; of <<= 1) { const int t = __shfl_down(incl, of); if (lane + of < 64) incl += t; }
            const int excl = incl - tot;
            if (excl < need && need <= incl) {
                int rem = need - excl, d;
                if (rem <= c3) d = 3; else { rem -= c3; if (rem <= c2) d = 2; else { rem -= c2; if (rem <= c1) d = 1; else { rem -= c1; d = 0; } } }
                sc[0] = prefix | ((unsigned)(4 * lane + d) << shift); sc[1] = (unsigned)rem;
            }
        }
        __syncthreads();
        prefix = sc[0]; need = (int)sc[1]; mask |= 255u << shift;
        __syncthreads();
    }
    const unsigned T = prefix; const int G = cap - need;
    unsigned cnt = 0u;
#pragma unroll
    for (int j = 0; j < VPT; ++j) if (active) cnt += (k[j] > T ? 1u : 0u) + (k[j] == T ? 0x10000u : 0u);
    unsigned incl = cnt;
#pragma unroll
    for (int of = 1; of < 64; of <<= 1) { const unsigned t = __shfl_up(incl, of); if (lane >= of) incl += t; }
    if (lane == 63) wsum[wave] = incl;
    __syncthreads();
    unsigned base = 0u;
#pragma unroll
    for (int q = 0; q < 8; ++q) if (q < wave) base += wsum[q];
    unsigned run = base + incl - cnt;
    int gtb = (int)(run & 0xffffu), eqb = (int)(run >> 16);
    if (active) {
#pragma unroll
        for (int j = 0; j < VPT; ++j) {
            const int i = tid * VPT + j, row = rowbase + i; int slot = -1;
            if (k[j] > T) slot = gtb++;
            else if (k[j] == T) { if (eqb < need) slot = G + eqb; ++eqb; }
            if (slot >= 0) { const int m = mbase + slot; WSP(int, OFF_RIDX)[e * MEXP + m] = row; WSP(float, OFF_GATE)[e * MEXP + m] = __uint_as_float(k[j] >> 2); WSP(int, OFF_SLOT)[row * 16 + e] = m; }
            else WSP(int, OFF_SLOT)[row * 16 + e] = -1;
        }
    }
    __syncthreads();
}
__device__ __forceinline__ void ph_topk(const int vc, const Params& p, LAS unsigned char* lds, bool with_ctx) {
    const int nitems = with_ctx ? 64 : 32;
    for (int it = vc; it < nitems; it += gridDim.x) {
        if (it < 32) { const int b = it >> 4, e = it & 15;
            topk_list<16>(p, lds, WSP(float, OFF_AFFL) + ((size_t)b * 16 + e) * SEQ, SEQ, CAPL, b * SEQ, b * CAPL, e);
            if (b == 0) { const int from = with_ctx ? 2 * CAPL + 2 * CAPC : 2 * CAPL;
                for (int m = from + tidx(); m < MEXP; m += NTHR) { WSP(int, OFF_RIDX)[e * MEXP + m] = 0; WSP(float, OFF_GATE)[e * MEXP + m] = 0.f; } }
        } else { const int q = it - 32, b = q >> 4, e = q & 15;
            topk_list<1>(p, lds, WSP(float, OFF_AFFC) + ((size_t)b * 16 + e) * CTX, CTX, CAPC, ML + b * CTX, 2 * CAPL + b * CAPC, e); }
    }
}

template <bool LAST>
__device__ __forceinline__ void ph_combine(const int vc, const Params& p, int layer, int rows) {
    const int tid = tidx(), wave = tid >> 6, lane = tid & 63;
    const int gw = vc * 8 + wave, NGW = gridDim.x * 8;
    const float* modl = WSP(float, OFF_MOD) + (size_t)layer * 3 * MODW;
    const float* modn = WSP(float, OFF_MOD) + (size_t)(layer + 1) * 3 * MODW;
    u32x2 xn[4]; int son = -1;
    auto prefetch = [&](int row) { const bf16_t* xr = WSP(bf16_t, OFF_X) + (size_t)row * D;
#pragma unroll
        for (int j = 0; j < 4; ++j) xn[j] = ((const u32x2*)xr)[lane + 64 * j];
        son = WSP(int, OFF_SLOT)[row * 16 + (lane & 15)]; };
    if (gw < rows) prefetch(gw);
    for (int row = gw; row < rows; row += NGW) {
        f32x4 v[4], acc[4];
#pragma unroll
        for (int j = 0; j < 4; ++j) { v[j] = (f32x4){__uint_as_float(xn[j].x << 16), __uint_as_float(xn[j].x & 0xffff0000u), __uint_as_float(xn[j].y << 16), __uint_as_float(xn[j].y & 0xffff0000u)}; acc[j] = (f32x4){0.f, 0.f, 0.f, 0.f}; }
        const int so = son;
        prefetch(row + NGW < rows ? row + NGW : row);
        auto add_row = [&](const u32x2 (&y)[4]) {
#pragma unroll
            for (int j = 0; j < 4; ++j) { acc[j][0] += __uint_as_float(y[j].x << 16); acc[j][1] += __uint_as_float(y[j].x & 0xffff0000u); acc[j][2] += __uint_as_float(y[j].y << 16); acc[j][3] += __uint_as_float(y[j].y & 0xffff0000u); } };
        if (!LAST && row >= ML) {
#pragma unroll 1
            for (int e = 0; e < 16; ++e) { const int m = __builtin_amdgcn_readlane(so, e);
                if (m >= 0) { const bf16_t* yr = WSP(bf16_t, OFF_YEB) + ((size_t)e * MEXP + m) * D;
#pragma unroll 1
                    for (int pt = 0; pt < 4; ++pt, yr += (size_t)64 * D) { u32x2 y[4];
#pragma unroll
                        for (int j = 0; j < 4; ++j) y[j] = __builtin_nontemporal_load((const u32x2*)yr + lane + 64 * j);
                        add_row(y); } } }
        } else {
            unsigned sel = (unsigned)__builtin_amdgcn_ballot_w64(so >= 0) & 0xffffu;
#pragma unroll 1
            while (sel) {
                const int e0 = __builtin_ctz(sel); sel &= sel - 1u;
                const bool two = sel != 0u; const int e1 = two ? __builtin_ctz(sel) : e0; if (two) sel &= sel - 1u;
                const bf16_t* y0p = WSP(bf16_t, OFF_YEB) + ((size_t)e0 * MEXP + __builtin_amdgcn_readlane(so, e0)) * D;
                const bf16_t* y1p = WSP(bf16_t, OFF_YEB) + ((size_t)e1 * MEXP + __builtin_amdgcn_readlane(so, e1)) * D;
                u32x2 y0[4], y1[4];
#pragma unroll
                for (int j = 0; j < 4; ++j) { y0[j] = __builtin_nontemporal_load((const u32x2*)y0p + lane + 64 * j); y1[j] = __builtin_nontemporal_load((const u32x2*)y1p + lane + 64 * j); }
                add_row(y0); if (two) add_row(y1);
            }
        }
        const float* m = modl + (row < ML ? row / SEQ : 2) * MODW + 5 * D;
#pragma unroll
        for (int j = 0; j < 4; ++j) v[j] = v[j] + ((const f32x4*)m)[lane + 64 * j] * acc[j];
        const float r = row_rms(v);
        if constexpr (LAST) {
#pragma unroll
            for (int j = 0; j < 4; ++j) __builtin_nontemporal_store(v[j] * r * ((const f32x4*)p.final_g)[lane + 64 * j], (f32x4*)(p.out + (size_t)row * D) + lane + 64 * j);
        } else {
            row_store_b(WSP(bf16_t, OFF_X) + (size_t)row * D, lane, v);
            const float* mn = modn + (row < ML ? row / SEQ : 2) * MODW; f32x4 o[4];
            row_mod_store(v, r, p.norm1_g + (layer + 1) * D, mn, mn + D, WSP(bf16_t, OFF_HB) + (size_t)row * D, lane, o);
        }
    }
}

typedef float f32x16 __attribute__((ext_vector_type(16)));
constexpr float NA_NEG = -1.0e30f, NA_C = 0.125f * 1.4426950408889634f;
template <bool NB, int R0, int R1>
__device__ __forceinline__ void na_tile(const f32x16& S, float& m_run, float& l_run, f32x16& O0, f32x16& O1, bf16x8 (&pf)[2], const LAS float* tabp, int mk) {
    float t[16];
    float mx = NA_NEG;
#pragma unroll
    for (int r = R0; r < R1; ++r) { const int kc = (r & 3) + 8 * (r >> 2);
        if (NB) { const float tv = S[r] * NA_C + tabp[kc]; t[r] = ((unsigned)(mk + kc) < 16u) ? tv : NA_NEG; } else t[r] = S[r] * NA_C;
        mx = fmaxf(mx, t[r]); }
    mx = half_max(mx);
    const float m_new = fmaxf(m_run, mx), alpha = __builtin_amdgcn_exp2f(m_run - m_new);
    float ps = 0.f; float pv[16];
#pragma unroll
    for (int r = 0; r < 16; ++r) { if (r >= R0 && r < R1) { pv[r] = __builtin_amdgcn_exp2f(t[r] - m_new); ps += pv[r]; } else pv[r] = 0.f; }
    ps = half_sum(ps);
    l_run = l_run * alpha + ps; m_run = m_new;
#pragma unroll
    for (int r = 0; r < 16; ++r) { O0[r] *= alpha; O1[r] *= alpha; }
#pragma unroll
    for (int s2 = 0; s2 < 2; ++s2) { u32x4 w; w.x = cvt_pk_bf16(pv[8 * s2 + 0], pv[8 * s2 + 1]); w.y = cvt_pk_bf16(pv[8 * s2 + 2], pv[8 * s2 + 3]); w.z = cvt_pk_bf16(pv[8 * s2 + 4], pv[8 * s2 + 5]); w.w = cvt_pk_bf16(pv[8 * s2 + 6], pv[8 * s2 + 7]);
        pf[s2] = __builtin_bit_cast(bf16x8, w); }
}
__device__ __forceinline__ void ph_na2(const int vc, const Params& p, LAS unsigned char* lds) {
    const int tid = tidx(), w = tid >> 6, l = tid & 63, lh = l >> 5, lc = l & 31;
    LAS float* tab = (LAS float*)(lds + w * 8192);
    const bf16_t* QN = WSP(bf16_t, R2_QK0); const bf16_t* KN = QN + (size_t)MT * 512; const bf16_t* VN = WSP(bf16_t, R2_VT0); bf16_t* AB = WSP(bf16_t, OFF_ABB);
    for (int it = vc * 8 + w; it < 2048 + 64; it += gridDim.x * 8) {
        const bool lat = it < 2048;
        int b, h, i = 0, qrow0;
        if (lat) { b = it >> 10; h = (it >> 7) & 7; i = it & 127; qrow0 = b * SEQ + i * 64; }
        else { const int q = it - 2048; b = q >> 5; h = (q >> 2) & 7; qrow0 = ML + b * CTX + (q & 3) * 64; }
        if (lat) {
#pragma unroll
            for (int k = 0; k < 30; ++k) { const int idx = l + 64 * k, r = idx >> 7, dc = (idx & 127) - 63; const bool in = dc >= -15 && dc <= 15;
                tab[idx] = in ? p.na_rpb[(h * 15 + r) * 31 + (in ? dc + 15 : 0)] * 1.4426950408889634f : 0.f; }
            lds_fence(); }
        bf16x8 qf[2][4];
#pragma unroll
        for (int qb = 0; qb < 2; ++qb)
#pragma unroll
            for (int ks = 0; ks < 4; ++ks) qf[qb][ks] = *(const bf16x8*)(QN + ((((size_t)((qrow0 >> 5) + qb) * 8 + h) * 4 + ks) * 64 + l) * 8);
        f32x16 O[2][2];
#pragma unroll
        for (int qb = 0; qb < 2; ++qb)
#pragma unroll
            for (int db = 0; db < 2; ++db)
#pragma unroll
                for (int r = 0; r < 16; ++r) O[qb][db][r] = 0.f;
        float m_run[2] = {NA_NEG, NA_NEG}, l_run[2] = {0.f, 0.f};
        const int r0 = min(max(i - 4, 0), 120);
        const int ntiles = lat ? 24 : 8;
        auto tile_row0 = [&](int tt) -> int { return tt >= 8 ? b * SEQ + (r0 + ((tt - 8) >> 1)) * 64 + 32 * (tt & 1) : ML + b * CTX + 32 * tt; };
        auto load_tile = [&](int krow0, bf16x8 (&kf)[4], bf16x8 (&vf)[2][2]) __attribute__((always_inline)) {
#pragma unroll
            for (int ks = 0; ks < 4; ++ks) kf[ks] = *(const bf16x8*)(KN + ((((size_t)(krow0 >> 5) * 8 + h) * 4 + ks) * 64 + l) * 8);
#pragma unroll
            for (int db = 0; db < 2; ++db)
#pragma unroll
                for (int s2 = 0; s2 < 2; ++s2) vf[db][s2] = *(const bf16x8*)(VN + (((((size_t)(krow0 >> 5) * 8 + h) * 2 + db) * 2 + s2) * 64 + l) * 8);
        };
        bf16x8 kf[4], vf[2][2], kn[4], vn[2][2];
        load_tile(tile_row0(0), kf, vf);
#pragma unroll 1
        for (int tt = 0; tt < ntiles; ++tt) {
            const bool nb = tt >= 8; const int kr = r0 + ((tt - 8) >> 1), half = tt & 1;
            load_tile(tile_row0(tt + 1 < ntiles ? tt + 1 : tt), kn, vn);
            bf16x8 p0[2], p1[2];
            const LAS float* trow = tab + (nb ? (kr - i + 7) * 128 : 0);
            const int cs0 = min(max(lc - 8, 0), 48), cs1 = min(max(lc + 24, 0), 48);
            const LAS float* tp0 = trow + (32 * half + 4 * lh - lc + 63); const LAS float* tp1 = tp0 - 32;
            const int mk0 = 32 * half + 4 * lh - cs0, mk1 = 32 * half + 4 * lh - cs1;
            {   f32x16 S;
#pragma unroll
                for (int r = 0; r < 16; ++r) S[r] = 0.f;
#pragma unroll
                for (int ks = 0; ks < 4; ++ks) S = __builtin_amdgcn_mfma_f32_32x32x16_bf16(kf[ks], qf[0][ks], S, 0, 0, 0);
                if (!nb) na_tile<false, 0, 16>(S, m_run[0], l_run[0], O[0][0], O[0][1], p0, tab, 0);
                else if (half == 0) na_tile<true, 0, 16>(S, m_run[0], l_run[0], O[0][0], O[0][1], p0, tp0, mk0);
                else na_tile<true, 0, 4>(S, m_run[0], l_run[0], O[0][0], O[0][1], p0, tp0, mk0);
            }
            __builtin_amdgcn_sched_barrier(0);
            {   f32x16 S;
#pragma unroll
                for (int r = 0; r < 16; ++r) S[r] = 0.f;
#pragma unroll
                for (int ks = 0; ks < 4; ++ks) S = __builtin_amdgcn_mfma_f32_32x32x16_bf16(kf[ks], qf[1][ks], S, 0, 0, 0);
                if (!nb) na_tile<false, 0, 16>(S, m_run[1], l_run[1], O[1][0], O[1][1], p1, tab, 0);
                else if (half == 0) na_tile<true, 12, 16>(S, m_run[1], l_run[1], O[1][0], O[1][1], p1, tp1, mk1);
                else na_tile<true, 0, 16>(S, m_run[1], l_run[1], O[1][0], O[1][1], p1, tp1, mk1);
            }
            __builtin_amdgcn_sched_barrier(0);
#pragma unroll
            for (int db = 0; db < 2; ++db) {
                if (!nb || half == 0) { O[0][db] = __builtin_amdgcn_mfma_f32_32x32x16_bf16(vf[db][0], p0[0], O[0][db], 0, 0, 0); O[0][db] = __builtin_amdgcn_mfma_f32_32x32x16_bf16(vf[db][1], p0[1], O[0][db], 0, 0, 0); }
                else O[0][db] = __builtin_amdgcn_mfma_f32_32x32x16_bf16(vf[db][0], p0[0], O[0][db], 0, 0, 0);
                if (!nb || half == 1) { O[1][db] = __builtin_amdgcn_mfma_f32_32x32x16_bf16(vf[db][0], p1[0], O[1][db], 0, 0, 0); O[1][db] = __builtin_amdgcn_mfma_f32_32x32x16_bf16(vf[db][1], p1[1], O[1][db], 0, 0, 0); }
                else O[1][db] = __builtin_amdgcn_mfma_f32_32x32x16_bf16(vf[db][1], p1[1], O[1][db], 0, 0, 0);
            }
#pragma unroll
            for (int ks = 0; ks < 4; ++ks) kf[ks] = kn[ks];
#pragma unroll
            for (int db = 0; db < 2; ++db)
#pragma unroll
                for (int s2 = 0; s2 < 2; ++s2) vf[db][s2] = vn[db][s2];
        }
#pragma unroll
        for (int qb = 0; qb < 2; ++qb) { const float inv = 1.f / l_run[qb]; bf16_t* orow = AB + (size_t)(qrow0 + 32 * qb + lc) * D + h * 64 + 4 * lh;
#pragma unroll
            for (int db = 0; db < 2; ++db)
#pragma unroll
                for (int g = 0; g < 4; ++g) { u32x2 wv; wv.x = cvt_pk_bf16(O[qb][db][4 * g] * inv, O[qb][db][4 * g + 1] * inv); wv.y = cvt_pk_bf16(O[qb][db][4 * g + 2] * inv, O[qb][db][4 * g + 3] * inv);
                    *(u32x2*)(orow + 32 * db + 8 * g) = wv; } }
        lds_fence();
    }
}

__device__ __forceinline__ void ph_sgu2(const int vc, const Params& p, LAS unsigned char* lds) {
    const int tid = tidx(), g = tid >> 6, l = tid & 63, lh = l >> 5, lc = l & 31;
    LAS float* part = (LAS float*)(lds + 65536); LAS float* rq = part + 32 * 128;
    const bf16_t* GVT = WSP(bf16_t, R2_GVT0); const bf16_t* U = WSP(bf16_t, R2_U0); const bf16_t* W = WSP(bf16_t, OFF_SGW) + (size_t)g * 16384; bf16_t* AB = WSP(bf16_t, OFF_ABB);
    for (int ch = (int)gridDim.x - 1 - vc; ch < MT / 128; ch += gridDim.x) {
        const int tok0 = ch * 128;
        {
            const int tg = tid & 15, rg = tid >> 4; float ss[8];
#pragma unroll
            for (int j = 0; j < 8; ++j) ss[j] = 0.f;
            const bf16_t* gp = GVT + (size_t)(rg * 16) * MT + tok0 + 8 * tg;
            u32x4 gv[16];
#pragma unroll
            for (int c = 0; c < 16; ++c) gv[c] = *(const u32x4*)(gp + (size_t)c * MT);
#pragma unroll
            for (int c = 0; c < 16; ++c) { const u32x4 v = gv[c];
                const float f0 = __uint_as_float(v.x << 16), f1 = __uint_as_float(v.x & 0xffff0000u), f2 = __uint_as_float(v.y << 16), f3 = __uint_as_float(v.y & 0xffff0000u);
                const float f4 = __uint_as_float(v.z << 16), f5 = __uint_as_float(v.z & 0xffff0000u), f6 = __uint_as_float(v.w << 16), f7 = __uint_as_float(v.w & 0xffff0000u);
                ss[0] += f0 * f0; ss[1] += f1 * f1; ss[2] += f2 * f2; ss[3] += f3 * f3; ss[4] += f4 * f4; ss[5] += f5 * f5; ss[6] += f6 * f6; ss[7] += f7 * f7; }
            *(LAS f32x4*)(part + rg * 128 + 8 * tg) = (f32x4){ss[0], ss[1], ss[2], ss[3]}; *(LAS f32x4*)(part + rg * 128 + 8 * tg + 4) = (f32x4){ss[4], ss[5], ss[6], ss[7]};
            __syncthreads();
            if (tid < 128) { float s = 0.f;
#pragma unroll
                for (int r = 0; r < 32; ++r) s += part[r * 128 + tid];
                rq[tid] = rsqrtf(s * (1.f / 512.f) + EPS); }
            __syncthreads();
        }
        bf16x8 af[2][8];
#pragma unroll
        for (int cb = 0; cb < 2; ++cb)
#pragma unroll
            for (int ks = 0; ks < 8; ++ks) { const u32x4 v = *(const u32x4*)(GVT + (size_t)(g * 64 + 32 * cb + lc) * MT + tok0 + 16 * ks + 8 * lh);
                const f32x4 k0 = *(const LAS f32x4*)(rq + 16 * ks + 8 * lh), k1 = *(const LAS f32x4*)(rq + 16 * ks + 8 * lh + 4);
                u32x4 sv;
                sv.x = cvt_pk_bf16(__uint_as_float(v.x << 16) * k0[0], __uint_as_float(v.x & 0xffff0000u) * k0[1]);
                sv.y = cvt_pk_bf16(__uint_as_float(v.y << 16) * k0[2], __uint_as_float(v.y & 0xffff0000u) * k0[3]);
                sv.z = cvt_pk_bf16(__uint_as_float(v.z << 16) * k1[0], __uint_as_float(v.z & 0xffff0000u) * k1[1]);
                sv.w = cvt_pk_bf16(__uint_as_float(v.w << 16) * k1[2], __uint_as_float(v.w & 0xffff0000u) * k1[3]);
                af[cb][ks] = __builtin_bit_cast(bf16x8, sv); }
#pragma unroll 1
        for (int pb = 0; pb < 4; ++pb) {
            f32x16 C0, C1;
#pragma unroll
            for (int r = 0; r < 16; ++r) { C0[r] = 0.f; C1[r] = 0.f; }
#pragma unroll
            for (int ks = 0; ks < 8; ++ks) { const bf16x8 bw = *(const bf16x8*)(W + (size_t)((pb * 8 + ks) * 64 + l) * 8);
                C0 = __builtin_amdgcn_mfma_f32_32x32x16_bf16(af[0][ks], bw, C0, 0, 0, 0); C1 = __builtin_amdgcn_mfma_f32_32x32x16_bf16(af[1][ks], bw, C1, 0, 0, 0); }
            const int pp = 32 * pb + lc, row = tok0 + pp; const float bias = p.sgu_b[g * 128 + pp];
#pragma unroll
            for (int cb = 0; cb < 2; ++cb)
#pragma unroll
                for (int q4 = 0; q4 < 4; ++q4) { const int c0 = g * 64 + 32 * cb + 8 * q4 + 4 * lh;
                    const u32x2 uu = *(const u32x2*)(U + (size_t)row * 512 + c0); const f32x4 sg = *(const f32x4*)(p.sgu_norm_g + c0);
                    const float u0 = __uint_as_float(uu.x << 16), u1 = __uint_as_float(uu.x & 0xffff0000u), u2 = __uint_as_float(uu.y << 16), u3 = __uint_as_float(uu.y & 0xffff0000u);
                    const f32x16& C = cb ? C1 : C0;
                    u32x2 wv; wv.x = cvt_pk_bf16(u0 * (sg[0] * C[4 * q4] + bias), u1 * (sg[1] * C[4 * q4 + 1] + bias)); wv.y = cvt_pk_bf16(u2 * (sg[2] * C[4 * q4 + 2] + bias), u3 * (sg[3] * C[4 * q4 + 3] + bias));
                    *(u32x2*)(AB + (size_t)row * D + 512 + c0) = wv; }
        }
        __syncthreads();
    }
}

__device__ __forceinline__ float ret_lg2(const Params& p, int dir, int h) { const float xl = p.ret_decay[dir * 4 + h]; return -log1pf(expf(-xl)) * 1.4426950408889634f; }

__device__ __forceinline__ void ph_att(const int vc, const Params& p, LAS unsigned char* lds, const int first) {
    const int tid = tidx(), w = __builtin_amdgcn_readfirstlane(tid >> 6), l = tid & 63, lq = l >> 4, lr = l & 15;
    const bf16_t* Qf = WSP(bf16_t, R2_Q); const bf16_t* Kf = WSP(bf16_t, R2_KN); bf16_t* ATT = WSP(bf16_t, O_ATT);
    const int nw = (int)gridDim.x - first, u0 = vc - first;
    if (u0 < 0) return;
    LAS bf16_t* Kl = (LAS bf16_t*)lds;
    auto stage = [&](int u, int buf) { const int b = u >> 8, h = (u >> 6) & 3, n = u & 63;
        const bf16_t* kg = Kf + ((size_t)((b * 4 + h) * 512 + n * 8) * 8) * 512;
#pragma unroll
        for (int i = 0; i < 8; ++i) __builtin_amdgcn_global_load_lds((const unsigned*)(kg + (size_t)((i * 8 + w) * 512 + l * 8)), (LAS unsigned*)(Kl + buf * 32768 + (i * 8 + w) * 512), 16, 0, 0); };
    if (u0 < 512) stage(u0, 0);
    if (u0 + nw < 512) stage(u0 + nw, 1);
#pragma unroll 1
    for (int j = 0; j < 3; ++j) { const int u = u0 + j * nw; if (u >= 512) break;
        asm volatile("s_waitcnt vmcnt(0)" ::: "memory");
        __syncthreads();
        const int b = u >> 8, h = (u >> 6) & 3, n = u & 63;
        const float lgf = ret_lg2(p, 0, h), lgb = ret_lg2(p, 1, h);
        const bf16_t* qb = Qf + ((size_t)((b * 4 + h) * 512 + n * 8 + w) * 8) * 512 + l * 8;
        const LAS bf16_t* kb = Kl + (j & 1) * 32768 + l * 8;
        bf16x8 qf[8];
#pragma unroll
        for (int ks = 0; ks < 8; ++ks) qf[ks] = *(const bf16x8*)(qb + ks * 512);
        bf16_t* af = ATT + ((size_t)((0 * 2 + b) * 4 + h) * 64 + n) * 16384 + (size_t)w * 4 * 512;
        bf16_t* ab = ATT + ((size_t)((1 * 2 + b) * 4 + h) * 64 + n) * 16384 + (size_t)w * 4 * 512;
        const int t = 16 * w + lr;
#pragma unroll 2
        for (int sb = 0; sb < 8; ++sb) {
            f32x4 c = {0.f, 0.f, 0.f, 0.f};
#pragma unroll
            for (int ks = 0; ks < 8; ++ks) { const bf16x8 kf = *(const LAS bf16x8*)(kb + (sb * 8 + ks) * 512); c = __builtin_amdgcn_mfma_f32_16x16x32_bf16(kf, qf[ks], c, 0, 0, 0); }
            const int s0 = 16 * sb + 4 * lq; float vf[4], vb[4];
#pragma unroll
            for (int r = 0; r < 4; ++r) { const int sx = s0 + r;
                vf[r] = sx <= t ? c[r] * __builtin_amdgcn_exp2f((float)(t - sx) * lgf) : 0.f;
                vb[r] = sx >= t ? c[r] * __builtin_amdgcn_exp2f((float)(sx - t) * lgb) : 0.f; }
            u32x2 wf, wb; wf.x = cvt_pk_bf16(vf[0], vf[1]); wf.y = cvt_pk_bf16(vf[2], vf[3]); wb.x = cvt_pk_bf16(vb[0], vb[1]); wb.y = cvt_pk_bf16(vb[2], vb[3]);
            const int off = (sb >> 1) * 512 + (lr + 16 * (2 * (sb & 1) + (lq >> 1))) * 8 + 4 * (lq & 1);
            *(u32x2*)(af + off) = wf; *(u32x2*)(ab + off) = wb;
        }
        if (j == 0 && u0 + 2 * nw < 512) { __syncthreads(); stage(u0 + 2 * nw, 0); }
    }
}

constexpr int RS_ST = 264, RS_VT = 136;
__device__ __forceinline__ void ph_rscan(const int vc, const Params& p, LAS unsigned char* lds) {
    const int tid = tidx(), w = __builtin_amdgcn_readfirstlane(tid >> 6), l = tid & 63;
    const int c = vc, combo = 2 * (c & 7) + ((c >> 3) >> 4), sl = (c >> 3) & 15;
    if (c >= 256) return;
    const int dir = combo & 1, h = (combo >> 1) & 3, b = combo >> 3;
    const bf16_t* Q = WSP(bf16_t, R2_Q); const bf16_t* KT = WSP(bf16_t, R2_KT); const bf16_t* VT = WSP(bf16_t, R2_VT);
    const bf16_t* ATT = WSP(bf16_t, O_ATT) + (size_t)((dir * 2 + b) * 4 + h) * 64 * 16384;
    bf16_t* Ob = WSP(bf16_t, O_OB) + (size_t)dir * ML * 2048;
    LAS bf16_t* STl = (LAS bf16_t*)lds;
    LAS bf16_t* VTl = (LAS bf16_t*)(lds + 2 * 32 * RS_ST * 2);
    LAS bf16_t* VSl = VTl + 2 * 32 * RS_VT;
    LAS float* kd = (LAS float*)(VSl + 2 * 32 * RS_VT); LAS float* qd = kd + 128;
    const float lg = ret_lg2(p, dir, h);
    if (tid < 128) { kd[tid] = __builtin_amdgcn_exp2f(lg * (float)(dir ? tid : 127 - tid)); qd[tid] = __builtin_amdgcn_exp2f(lg * (float)(dir ? 128 - tid : tid + 1)); }
    const float cd = __builtin_amdgcn_exp2f(lg * 128.f);
    for (int i = tid; i < 32 * RS_ST; i += NTHR) STl[i] = 0;
    __syncthreads();
    auto tokbase = [&](int si) -> int { if (si < 2) { const int cn = dir ? 1 - si : si; return ML + b * CTX + 128 * cn; } const int n = si - 2; return b * SEQ + 128 * (dir ? 63 - n : n); };
    auto chunk_of = [&](int si) -> int { const int n = si - 2; return dir ? 63 - n : n; };
    const int vdv = tid >> 4, vt0 = (tid & 15) * 8;
    const bf16_t* vrow = VT + (size_t)(h * 512 + sl * 32 + vdv) * MT + vt0;
    auto stage_v = [&](u32x4 v, int buf) {
        *(LAS u32x4*)(VTl + (buf * 32 + vdv) * RS_VT + vt0) = v;
        const f32x4 k0 = *(const LAS f32x4*)(kd + vt0), k1 = *(const LAS f32x4*)(kd + vt0 + 4);
        u32x4 s;
        s.x = cvt_pk_bf16(__uint_as_float(v.x << 16) * k0[0], __uint_as_float(v.x & 0xffff0000u) * k0[1]);
        s.y = cvt_pk_bf16(__uint_as_float(v.y << 16) * k0[2], __uint_as_float(v.y & 0xffff0000u) * k0[3]);
        s.z = cvt_pk_bf16(__uint_as_float(v.z << 16) * k1[0], __uint_as_float(v.z & 0xffff0000u) * k1[1]);
        s.w = cvt_pk_bf16(__uint_as_float(v.w << 16) * k1[2], __uint_as_float(v.w & 0xffff0000u) * k1[3]);
        *(LAS u32x4*)(VSl + (buf * 32 + vdv) * RS_VT + vt0) = s;
    };
    f32x16 S;
#pragma unroll
    for (int i = 0; i < 16; ++i) S[i] = 0.f;
    { const u32x4 v0 = *(const u32x4*)(vrow + tokbase(0)); stage_v(v0, 0); }
    bf16x8 qA[8], qB[8], af[4], kf[8];
#pragma unroll
    for (int i = 0; i < 8; ++i) { qA[i] = (bf16x8){0, 0, 0, 0, 0, 0, 0, 0}; qB[i] = qA[i]; }
#pragma unroll
    for (int i = 0; i < 4; ++i) af[i] = (bf16x8){0, 0, 0, 0, 0, 0, 0, 0};
    { const bf16_t* kp = KT + (((size_t)h * 132 + (tokbase(0) >> 7)) * 8 + w) * 8 * 512 + l * 8;
#pragma unroll
      for (int ks = 0; ks < 8; ++ks) kf[ks] = *(const bf16x8*)(kp + ks * 512); }
    auto att_need = [&](int ks) -> bool { return dir ? ks >= (w >> 1) : ks <= ((16 * w + 15) >> 5); };
    constexpr int NSTEP = 66;
    bf16_t* dump = WSP(bf16_t, OFF_VN);
    auto step = [&](const int si, const bf16x8 (&qf)[8], bf16x8 (&qn)[8]) __attribute__((always_inline)) {
        const int cur = si & 1;
        __syncthreads();
        const int sn = si + 1 < NSTEP ? si + 1 : si; const int tbn = tokbase(sn); const int cn = sn < 2 ? (dir ? 63 : 0) : chunk_of(sn);
        const u32x4 vnext = *(const u32x4*)(vrow + tbn);
        { const bf16_t* qp = Q + (((size_t)(b * 4 + h) * 512 + cn * 8 + w) * 8) * 512 + l * 8;
#pragma unroll
          for (int ks = 0; ks < 8; ++ks) qn[ks] = *(const bf16x8*)(qp + ks * 512); }
        f32x4 oi[2], oa[2];
#pragma unroll
        for (int nt = 0; nt < 2; ++nt) { oi[nt] = (f32x4){0.f, 0.f, 0.f, 0.f}; oa[nt] = (f32x4){0.f, 0.f, 0.f, 0.f}; }
        {   bf16x8 bs[16];
#pragma unroll
            for (int ks = 0; ks < 8; ++ks)
#pragma unroll
                for (int nt = 0; nt < 2; ++nt) bs[2 * ks + nt] = *(const LAS bf16x8*)(STl + (cur * 32 + 16 * nt + (l & 15)) * RS_ST + 32 * ks + 8 * (l >> 4));
            __builtin_amdgcn_sched_barrier(0);
#pragma unroll
            for (int ks = 0; ks < 8; ++ks)
#pragma unroll
                for (int nt = 0; nt < 2; ++nt) oi[nt] = __builtin_amdgcn_mfma_f32_16x16x32_bf16(bs[2 * ks + nt], qf[ks], oi[nt], 0, 0, 0);
        }
        __builtin_amdgcn_sched_barrier(0);
        bf16x8 bv[8], vs[8];
#pragma unroll
        for (int ks = 0; ks < 4; ++ks)
#pragma unroll
            for (int nt = 0; nt < 2; ++nt) bv[2 * ks + nt] = *(const LAS bf16x8*)(VTl + (cur * 32 + 16 * nt + (l & 15)) * RS_VT + 32 * ks + 8 * (l >> 4));
#pragma unroll
        for (int ks = 0; ks < 8; ++ks) vs[ks] = *(const LAS bf16x8*)(VSl + (cur * 32 + (l & 31)) * RS_VT + 16 * ks + 8 * (l >> 5));
#pragma unroll
        for (int i = 0; i < 16; ++i) S[i] *= cd;
        __builtin_amdgcn_sched_barrier(0);
#pragma unroll
        for (int ks = 0; ks < 8; ++ks) {
            S = __builtin_amdgcn_mfma_f32_32x32x16_bf16(kf[ks], vs[ks], S, 0, 0, 0);
            if (ks < 4 && att_need(ks)) {
#pragma unroll
                for (int nt = 0; nt < 2; ++nt) oa[nt] = __builtin_amdgcn_mfma_f32_16x16x32_bf16(bv[2 * ks + nt], af[ks], oa[nt], 0, 0, 0); }
        }
        __builtin_amdgcn_sched_barrier(0);
        { const bf16_t* apn = ATT + (size_t)cn * 16384 + (size_t)w * 4 * 512 + l * 8;
#pragma unroll
          for (int ks = 0; ks < 4; ++ks) { const int kse = att_need(ks) ? ks : (dir ? 3 : 0);
              af[ks] = *(const bf16x8*)(apn + kse * 512); }
          const bf16_t* kp = KT + (((size_t)h * 132 + (tbn >> 7)) * 8 + w) * 8 * 512 + l * 8;
#pragma unroll
          for (int ks = 0; ks < 8; ++ks) kf[ks] = *(const bf16x8*)(kp + ks * 512); }
        {
            bf16_t* obase = si < 2 ? dump : Ob + (size_t)tokbase(si) * 2048;
            const int t = 16 * w + (l & 15); const float qs = qd[t];
            bf16_t* orow = obase + (size_t)t * 2048 + h * 512 + sl * 32 + 4 * (l >> 4);
#pragma unroll
            for (int nt = 0; nt < 2; ++nt) { const f32x4 o = oi[nt] * qs + oa[nt]; u32x2 wv; wv.x = cvt_pk_bf16(o[0], o[1]); wv.y = cvt_pk_bf16(o[2], o[3]); *(u32x2*)(orow + 16 * nt) = wv; }
        }
#pragma unroll
        for (int g = 0; g < 4; ++g) { u32x2 wv; wv.x = cvt_pk_bf16(S[4 * g], S[4 * g + 1]); wv.y = cvt_pk_bf16(S[4 * g + 2], S[4 * g + 3]);
            *(LAS u32x2*)(STl + ((cur ^ 1) * 32 + (l & 31)) * RS_ST + 32 * w + 8 * g + 4 * (l >> 5)) = wv; }
        stage_v(vnext, cur ^ 1);
    };
    __builtin_amdgcn_s_waitcnt(0x0F70);
#pragma unroll 1
    for (int si = 0; si < NSTEP; si += 2) { step(si, qA, qB); step(si + 1, qB, qA); }
    __syncthreads();
}

__device__ __forceinline__ void ph_retout(const int vc, const Params& p) {
    const bf16_t* Gs = WSP(bf16_t, O_GS); const bf16_t* Ob = WSP(bf16_t, O_OB);
    const int tid_ = tidx(), wave = tid_ >> 6, lane = tid_ & 63;
    const int it0 = vc * 8 + wave, its = (int)gridDim.x * 8;
    auto off_of = [&](int it) -> size_t { return (size_t)(it >> 2) * 2048 + (it & 3) * 512 + 8 * lane; };
    u32x4 an = __builtin_nontemporal_load((const u32x4*)(Ob + off_of(it0))), bn = __builtin_nontemporal_load((const u32x4*)(Ob + (size_t)ML * 2048 + off_of(it0))), gn = __builtin_nontemporal_load((const u32x4*)(Gs + off_of(it0)));
    for (int it = it0; it < ML * 4; it += its) {
        const size_t o = off_of(it);
        const u32x4 a = an, bq = bn, g = gn;
        { const size_t on = off_of(it + its < ML * 4 ? it + its : it);
          an = __builtin_nontemporal_load((const u32x4*)(Ob + on)); bn = __builtin_nontemporal_load((const u32x4*)(Ob + (size_t)ML * 2048 + on)); gn = __builtin_nontemporal_load((const u32x4*)(Gs + on)); }
        const f32x4 s0 = {__uint_as_float(a.x << 16) + __uint_as_float(bq.x << 16), __uint_as_float(a.x & 0xffff0000u) + __uint_as_float(bq.x & 0xffff0000u),
                          __uint_as_float(a.y << 16) + __uint_as_float(bq.y << 16), __uint_as_float(a.y & 0xffff0000u) + __uint_as_float(bq.y & 0xffff0000u)};
        const f32x4 s1 = {__uint_as_float(a.z << 16) + __uint_as_float(bq.z << 16), __uint_as_float(a.z & 0xffff0000u) + __uint_as_float(bq.z & 0xffff0000u),
                          __uint_as_float(a.w << 16) + __uint_as_float(bq.w << 16), __uint_as_float(a.w & 0xffff0000u) + __uint_as_float(bq.w & 0xffff0000u)};
        const float ss = (s0[0] * s0[0] + s0[1] * s0[1]) + (s0[2] * s0[2] + s0[3] * s0[3]) + (s1[0] * s1[0] + s1[1] * s1[1]) + (s1[2] * s1[2] + s1[3] * s1[3]);
        const float r = rsqrtf(wave_sum(ss) * (1.f / 512.f) + EPS);
        f32x4 g0 = {__uint_as_float(g.x << 16), __uint_as_float(g.x & 0xffff0000u), __uint_as_float(g.y << 16), __uint_as_float(g.y & 0xffff0000u)};
        f32x4 g1 = {__uint_as_float(g.z << 16), __uint_as_float(g.z & 0xffff0000u), __uint_as_float(g.w << 16), __uint_as_float(g.w & 0xffff0000u)};
#pragma unroll
        for (int j = 0; j < 4; ++j) { g0[j] = silu_fast(g0[j]); g1[j] = silu_fast(g1[j]); }
        *(u32x4*)(WSP(bf16_t, OFF_A2B) + o) = pg8::pack8(g0 * s0 * r, g1 * s1 * r);
    }
}

__device__ __forceinline__ void ph_gemm_in0(const int vc, const Params& p, LAS unsigned char* lds) {
    {   pg8::L0NormOrder S; S.init(gridDim.x, vc);
        pg8::gemm_phase<pg8::EpiZ0, pg8::L0NormOrder, false>(lds, (LAS int*)(lds + LDS_STAGE), pg8::Gemm{WSP(bf16_t, OFF_HB), WSP(bf16_t, OFF_WIN0), 0, 0, nullptr, 0, D}, S, pg8::EpiZ0{WSP(bf16_t, R2_QK0), WSP(bf16_t, R2_QK0) + (size_t)MT * 512, WSP(bf16_t, R2_U0)}); }
    __syncthreads();
    {   pg8::L0SwapOrder S; S.init(gridDim.x, vc);
        pg8::gemm_phase<pg8::EpiL0Swap, pg8::L0SwapOrder, false, 1 << 30, false, 1>(lds, (LAS int*)(lds + LDS_STAGE), pg8::Gemm{WSP(bf16_t, OFF_WIN0), WSP(bf16_t, OFF_HB), 0, 0, nullptr, 0, D}, S, pg8::EpiL0Swap{WSP(bf16_t, R2_VT0), WSP(bf16_t, R2_GVT0)}); }
}
__device__ __forceinline__ void ph_gemm_out0(const int vc, const Params& p, LAS unsigned char* lds) {
    const pg8::Gemm g{WSP(bf16_t, OFF_ABB), WSP(bf16_t, OFF_WOUT0), 0, 0, nullptr, 0, D};
    const EpiResNorm<0> E{p.ws, p.norm2_g, p.moe_router, p.x, p.ctx};
    {   pg8::PlainOrder S; S.init(ML / 256, D / 256, gridDim.x, vc);
        pg8::gemm_phase<EpiResNorm<0>, pg8::PlainOrder, false>(lds, (LAS int*)(lds + LDS_STAGE), g, S, E); }
    __syncthreads();
    {   pg8::SwapOrder S; S.init(64, 2, 0, 4, gridDim.x, vc);
        pg8::gemm_phase<EpiResNorm<0>, pg8::SwapOrder, false>(lds, (LAS int*)(lds + LDS_STAGE), g, S, E); }
}
__device__ __forceinline__ void ph_gemm_in1(const int vc, const Params& p, LAS unsigned char* lds) {
    {
        pg8::L1NormOrder S; S.init(gridDim.x, vc);
        pg8::gemm_phase<pg8::EpiL1In, pg8::L1NormOrder, false>(lds, (LAS int*)(lds + LDS_STAGE), pg8::Gemm{WSP(bf16_t, OFF_HB), WSP(bf16_t, OFF_WIN1), 0, 0, nullptr, 0, D}, S,
            pg8::EpiL1In{WSP(bf16_t, R2_Q), WSP(bf16_t, R2_KN), nullptr, WSP(bf16_t, O_GS), WSP(f32x2, OFF_ROPE)});
    }
    __syncthreads();
    {
        pg8::SwapOrder S; S.init(4, 12, 0, 64, gridDim.x, vc);
        pg8::gemm_phase<pg8::EpiL1Swap, pg8::SwapOrder, false, 1 << 30, false, 1>(lds, (LAS int*)(lds + LDS_STAGE), pg8::Gemm{WSP(bf16_t, OFF_WIN1), WSP(bf16_t, OFF_HB), 0, 0, nullptr, 0, D}, S,
            pg8::EpiL1Swap{WSP(bf16_t, R2_KT), WSP(bf16_t, R2_VT), WSP(f32x2, OFF_ROPE), WSP(f32x2, OFF_ROPE2), WSP(bf16_t, R2_KN), lds + LDS_STAGE});
    }
}
__device__ __forceinline__ void ph_att_ctxkv(const int vc, const Params& p, LAS unsigned char* lds) {
    if (gridDim.x == 256 && vc >= 48) { ph_att(vc, p, lds, 48); return; }
    if (gridDim.x != 256) { ph_att(vc, p, lds, 0); __syncthreads(); }
    const pg8::Gemm g{WSP(bf16_t, OFF_WIN1), WSP(bf16_t, OFF_HB), 0, 0, nullptr, 0, D};
    const pg8::EpiL1Swap E{WSP(bf16_t, R2_KT), WSP(bf16_t, R2_VT), WSP(f32x2, OFF_ROPE), WSP(f32x2, OFF_ROPE2), WSP(bf16_t, R2_KN), lds + LDS_STAGE};
    if (gridDim.x == 256) { pg8::CtxKvOrder S; S.init(vc); pg8::gemm_phase<pg8::EpiL1Swap, pg8::CtxKvOrder, false, 1 << 30, false, 1, true>(lds, (LAS int*)(lds + LDS_STAGE), g, S, E); }
    else { pg8::SwapOrder S; S.init(4, 12, 64, 2, gridDim.x, vc); pg8::gemm_phase<pg8::EpiL1Swap, pg8::SwapOrder, false, 1 << 30, false, 1>(lds, (LAS int*)(lds + LDS_STAGE), g, S, E); }
}
__device__ __forceinline__ void ph_gemm_out1(const int vc, const Params& p, LAS unsigned char* lds) {
    pg8::PlainOrder S; S.init(ML / 256, D / 256, gridDim.x, vc);
    pg8::gemm_phase<EpiResNorm<1>, pg8::PlainOrder, false>(lds, (LAS int*)(lds + LDS_STAGE), pg8::Gemm{WSP(bf16_t, OFF_A2B), WSP(bf16_t, OFF_WOUT1), 0, 0, nullptr, 0, 2048}, S, EpiResNorm<1>{p.ws, p.norm2_g + D, p.moe_router + (size_t)D * NE, nullptr, nullptr});
}
__device__ __forceinline__ void ph_gemm_gu(const int vc, const Params& p, LAS unsigned char* lds, int layer) {
    pg8::GroupedOrder S; S.init(layer ? 8 : 9, 22, 2, gridDim.x, vc);
    pg8::gemm_phase<pg8::EpiGU, pg8::GroupedOrder, true, 8>(lds, (LAS int*)(lds + LDS_STAGE), pg8::Gemm{WSP(bf16_t, OFF_HB), WSP(bf16_t, OFF_GUT) + (size_t)layer * GUT_L, 0, (size_t)2 * FF * D, WSP(int, OFF_RIDX), MEXP, D}, S, pg8::EpiGU{WSP(bf16_t, OFF_R2)});
}
__device__ __forceinline__ void ph_gemm_dn(const int vc, const Params& p, LAS unsigned char* lds, int layer) {
    const pg8::Gemm g{WSP(bf16_t, OFF_R2), WSP(bf16_t, OFF_DNT) + (size_t)layer * DNT_L, (size_t)MEXP * FF, (size_t)D * FF, nullptr, 0, FF};
    const pg8::EpiDown E{WSP(bf16_t, OFF_YEB), WSP(float, OFF_GATE)};
    if (layer == 0) { pg8::DnSplitOrder S; S.init(gridDim.x, vc); pg8::gemm_phase<pg8::EpiDown, pg8::DnSplitOrder, false, 8, true, 3>(lds, (LAS int*)(lds + LDS_STAGE), g, S, E); }
    else { pg8::GroupedOrder S; S.init(8, 4, 4, gridDim.x, vc); pg8::gemm_phase<pg8::EpiDown, pg8::GroupedOrder, false, 1 << 30, false, 3>(lds, (LAS int*)(lds + LDS_STAGE), g, S, E); }
}

constexpr int NPHASE = 18;
template <int PH>
__device__ __forceinline__ void run_phase(const int vc, const Params& p, LAS unsigned char* lds) {
    if constexpr (PH == 0) ph_prologue(vc, p, lds);
    if constexpr (PH == 1) ph_normmod<false, true>(vc, p, lds, 0, MT, p.norm1_g, 0, D);
    if constexpr (PH == 2) ph_gemm_in0(vc, p, lds);
    if constexpr (PH == 3) { ph_sgu2(vc, p, lds); ph_na2(vc, p, lds); }
    if constexpr (PH == 4) ph_gemm_out0(vc, p, lds);
    if constexpr (PH == 5) ph_topk(vc, p, lds, true);
    if constexpr (PH == 6) ph_gemm_gu(vc, p, lds, 0);
    if constexpr (PH == 7) ph_gemm_dn(vc, p, lds, 0);
    if constexpr (PH == 8) ph_combine<false>(vc, p, 0, MT);
    if constexpr (PH == 9) ph_gemm_in1(vc, p, lds);
    if constexpr (PH == 10) ph_att_ctxkv(vc, p, lds);
    if constexpr (PH == 11) ph_rscan(vc, p, lds);
    if constexpr (PH == 12) ph_retout(vc, p);
    if constexpr (PH == 13) ph_gemm_out1(vc, p, lds);
    if constexpr (PH == 14) ph_topk(vc, p, lds, false);
    if constexpr (PH == 15) ph_gemm_gu(vc, p, lds, 1);
    if constexpr (PH == 16) ph_gemm_dn(vc, p, lds, 1);
    if constexpr (PH == 17) ph_combine<true>(vc, p, 1, ML);
}

template <int PH> __device__ __forceinline__ void run_all(const int vc, const Params& p, LAS unsigned char* lds, const XcdBarrier& bar) {
    run_phase<PH>(vc, p, lds);
    if constexpr (PH + 1 < NPHASE) { xcd_barrier(bar); run_all<PH + 1>(vc, p, lds, bar); }
}

__global__ __launch_bounds__(NTHR, 2) void mega(Params p) {
    extern __shared__ __attribute__((aligned(16))) unsigned char smem[];
    LAS unsigned char* lds = (LAS unsigned char*)smem;
    volatile LAS unsigned* st = (volatile LAS unsigned*)(lds + LDS_BYTES - 16);
    if (threadIdx.x == 0) { st[0] = 0u; st[1] = 0u; st[2] = 0u; st[3] = 0u; }
    __syncthreads();
    XcdBarrier bar; bar.bar = WSP(unsigned, OFF_BAR); bar.x = xb_xcc_id(); bar.st = st;
    if (threadIdx.x == 0) st[2] = xb_add(&bar.bar[XB_XCNT(bar.x)], 1u);
    run_phase<0>((int)blockIdx.x, p, lds);
    xcd_barrier(bar);
    if (threadIdx.x == 0) {
        bool uni = gridDim.x == 256;
#pragma unroll
        for (unsigned j = 0; j < 16; ++j) { const unsigned cnt = xb_ld(&bar.bar[XB_XCNT(j)]); uni = uni && (cnt == (j < 8 ? 32u : 0u)); }
        st[3] = uni ? st[2] * 8u + bar.x : blockIdx.x;
    }
    __syncthreads();
    const int vc = (int)st[3];
    run_all<1>(vc, p, lds, bar);
}
}

extern "C" void kernel_launch(void* const* d_in, const int* in_sizes, int n_in, void* d_out, int out_size, void* d_ws, size_t ws_size, hipStream_t stream) {
    Params p{};
    p.x = (const float*)d_in[0]; p.c = (const float*)d_in[1]; p.ctx = (const float*)d_in[2]; p.c_ctx = (const float*)d_in[3];
    p.ada_w = (const float*)d_in[4]; p.ada_b = (const float*)d_in[5]; p.norm1_g = (const float*)d_in[6]; p.norm2_g = (const float*)d_in[7];
    p.ab_w_in = (const float*)d_in[8]; p.ab_w_out = (const float*)d_in[9]; p.na_rpb = (const float*)d_in[10]; p.sgu_norm_g = (const float*)d_in[11];
    p.sgu_w = (const float*)d_in[12]; p.sgu_b = (const float*)d_in[13]; p.ret_w_in = (const float*)d_in[14]; p.ret_w_out = (const float*)d_in[15];
    p.ret_decay = (const float*)d_in[16]; p.moe_router = (const float*)d_in[17]; p.moe_w_gate = (const float*)d_in[18]; p.moe_w_up = (const float*)d_in[19];
    p.moe_w_down = (const float*)d_in[20]; p.final_g = (const float*)d_in[21];
    p.out = (float*)d_out;
    p.ws = (char*)d_ws;

    if (ws_size < WS_END) { fprintf(stderr, "kernel_launch: workspace of %zu bytes is smaller than the %zu bytes this kernel needs; nothing launched\n", ws_size, (size_t)WS_END); return; }
    static bool attr_done = false;
    if (!attr_done) { (void)hipFuncSetAttribute((const void*)mega, hipFuncAttributeMaxDynamicSharedMemorySize, LDS_BYTES); attr_done = true; }
    (void)hipMemsetAsync(p.ws + OFF_BAR, 0, ZERO_BYTES, stream);
    hipLaunchKernelGGL(mega, dim3(NWG), dim3(NTHR), LDS_BYTES, stream, p);
}
```
